# Optimizing an MI355X kernel written in HIP

```python
import math
import jax, jax.numpy as jnp
from jax import lax
import numpy as np

D_MODEL = 1024
BATCH = 32
SEQ = 256
DEPTH = 2
DEC_BATCH = 8
DEC_SEQ = 4096
PAST_LEN = 512

GRID_W = 64
BRANCH_W = 512
N_BRANCH = 3
H_RET = 4
RET_DK = 64
RET_DV = 128
RET_CHUNK = 128
H_DIFF = 4
DIFF_HD = 64
H_MLA = 8
MLA_NOPE = 64
MLA_ROPE = 32
MLA_V = 64
Q_LORA = 384
KV_LORA = 256
MLA_SCALE = (MLA_NOPE + MLA_ROPE) ** -0.5
D_FF = -(-8 * D_MODEL // (3 * 256)) * 256
Q_BLOCK = 128
ROPE_BASE = 10000.0
EPS = 1e-6
IN_SIZES = (H_RET * RET_DK, H_RET * RET_DK, H_RET * RET_DV, H_RET * RET_DV,
            H_DIFF * 2 * DIFF_HD, H_DIFF * 2 * DIFF_HD, H_DIFF * 2 * DIFF_HD,
            Q_LORA, KV_LORA, MLA_ROPE, N_BRANCH * D_MODEL)
N_IN = sum(IN_SIZES)

kernel_name = 'hybrid_ret_diff_mla_dit_step'


def _rmsnorm(x, g):
    xf = x.astype(jnp.float32)
    y = xf * lax.rsqrt(jnp.mean(xf * xf, axis=-1, keepdims=True) + EPS)
    return (y * g.astype(jnp.float32)).astype(x.dtype)


def _head_rmsnorm(o):
    of = o.astype(jnp.float32)
    return of * lax.rsqrt(jnp.mean(of * of, axis=-1, keepdims=True) + EPS)


def _group_layernorm(o):
    mu = jnp.mean(o, axis=-1, keepdims=True)
    var = jnp.mean(jnp.square(o - mu), axis=-1, keepdims=True)
    return (o - mu) * lax.rsqrt(var + EPS)


def _adaln(cond, w, b):
    return jax.nn.silu(cond) @ w + b


def _axial_rope_tables(n_tokens, rot_dim):
    t = jnp.arange(n_tokens)
    row = (t // GRID_W).astype(jnp.float32)
    col = (t % GRID_W).astype(jnp.float32)
    nf = rot_dim // 4
    inv = ROPE_BASE ** (-jnp.arange(nf, dtype=jnp.float32) / nf)
    ang = jnp.concatenate([row[:, None] * inv, col[:, None] * inv], axis=-1)
    return jnp.cos(ang), jnp.sin(ang)


def _rope(x, cos, sin):
    shape = (x.shape[1],) + (1,) * (x.ndim - 3) + (cos.shape[-1],)
    c = cos.reshape(shape).astype(x.dtype)
    s = sin.reshape(shape).astype(x.dtype)
    x1, x2 = jnp.split(x, 2, axis=-1)
    return jnp.concatenate([x1 * c - x2 * s, x2 * c + x1 * s], axis=-1)


def _retention(q, k, v, decay_logit, s0, strict):
    B, S, H, _ = q.shape
    dv = v.shape[-1]
    C = RET_CHUNK
    n = S // C
    lg = jax.nn.log_sigmoid(decay_logit.astype(jnp.float32))
    i = jnp.arange(C, dtype=jnp.float32)
    dist = i[:, None] - i[None, :]
    mask = (dist > 0) if strict else (dist >= 0)
    dmat = jnp.where(mask[None], jnp.exp(jnp.maximum(dist, 0.0)[None] * lg[:, None, None]), 0.0)
    xi = jnp.exp((i + 1.0)[:, None] * lg[None, :])[None, :, :, None]
    zeta = jnp.exp((C - 1.0 - i)[:, None] * lg[None, :])[None, :, :, None]
    g_chunk = jnp.exp(C * lg)[None, :, None, None]

    def chunks(a):
        return jnp.moveaxis(a.astype(jnp.float32).reshape((B, n, C) + a.shape[2:]), 1, 0)

    def step(s, qkv):
        qc, kc, vc = qkv
        sc = jnp.einsum('bihd,bjhd->bhij', qc, kc) * dmat
        inner = jnp.einsum('bhij,bjhe->bihe', sc, vc)
        cross = jnp.einsum('bihd,bhde->bihe', qc, s) * xi
        s_new = g_chunk * s + jnp.einsum('bjhd,bjhe->bhde', kc * zeta, vc)
        return s_new, inner + cross

    s_fin, out = lax.scan(step, s0.astype(jnp.float32), (chunks(q), chunks(k), chunks(v)))
    return jnp.moveaxis(out, 0, 1).reshape(B, S, H, dv), s_fin


def _query_blocks(fn, *qs):
    B, S = qs[0].shape[:2]
    nb = S // Q_BLOCK
    blocks = tuple(jnp.moveaxis(q.reshape((B, nb, Q_BLOCK) + q.shape[2:]), 1, 0) for q in qs)
    out = lax.map(lambda a: fn(*a), blocks)
    return jnp.moveaxis(out, 0, 1).reshape((B, S) + out.shape[3:])


def _diff_attention(q, k, v, lam, lam_init):
    s = jnp.einsum('bqhcd,bkhcd->bhcqk', q, k).astype(jnp.float32) * DIFF_HD ** -0.5
    p = jax.nn.softmax(s, axis=-1)
    a = p[:, :, 0] - lam * p[:, :, 1]
    o = jnp.einsum('bhqk,bkhe->bqhe', a.astype(v.dtype), v)
    return (_head_rmsnorm(o) * (1.0 - lam_init)).astype(v.dtype)


def _mla_attention(q_nope, q_pe, k_nope, k_pe, v):
    s = jnp.einsum('bqhd,bkhd->bhqk', q_nope, k_nope) + jnp.einsum('bqhr,bkr->bhqk', q_pe, k_pe)
    p = jax.nn.softmax(s.astype(jnp.float32) * MLA_SCALE, axis=-1)
    return jnp.einsum('bhqk,bkhe->bqhe', p.astype(v.dtype), v)


def _swiglu(h, w_in, w_out):
    a, b = jnp.split(h @ w_in, 2, axis=-1)
    return (jax.nn.silu(a) * b) @ w_out


def _mixers(h, lw, lam_init, rope, ctx):
    B, S, _ = h.shape
    idx = np.cumsum(IN_SIZES)[:-1].tolist()
    rq, rk, rv, rg, dq, dk, dv, cq, ckv, kpe, gate_logits = jnp.split(h @ lw['w_in'], idx, axis=-1)

    rq = rq.reshape(B, S, H_RET, RET_DK)
    rk = rk.reshape(B, S, H_RET, RET_DK) * RET_DK ** -0.5
    rv = rv.reshape(B, S, H_RET, RET_DV)
    dq = dq.reshape(B, S, H_DIFF, 2, DIFF_HD)
    dk = dk.reshape(B, S, H_DIFF, 2, DIFF_HD)
    dv = dv.reshape(B, S, H_DIFF, 2 * DIFF_HD)
    q_mla = (_rmsnorm(cq, lw['mla_q_norm']) @ lw['w_uq']).reshape(B, S, H_MLA, MLA_NOPE + MLA_ROPE)
    q_nope, q_pe = jnp.split(q_mla, [MLA_NOPE], axis=-1)
    ckv = _rmsnorm(ckv, lw['mla_kv_norm'])

    if rope is not None:
        (c64, s64), (c32, s32) = rope
        rq, rk = _rope(rq, c64, s64), _rope(rk, c64, s64)
        dq, dk = _rope(dq, c64, s64), _rope(dk, c64, s64)
        q_pe, kpe = _rope(q_pe, c32, s32), _rope(kpe, c32, s32)

    if ctx is None:
        s_f0 = jnp.zeros((B, H_RET, RET_DK, RET_DV), jnp.float32)
        s_b0 = s_f0
        dk_all, dv_all, ckv_all, kpe_all = dk, dv, ckv, kpe
    else:
        s_f0, s_b0, ck, cv, cckv, ckpe = ctx
        L = ck.shape[1]
        dk_all = jnp.concatenate([ck.reshape(B, L, H_DIFF, 2, DIFF_HD), dk], axis=1)
        dv_all = jnp.concatenate([cv, dv], axis=1)
        ckv_all = jnp.concatenate([cckv, ckv], axis=1)
        kpe_all = jnp.concatenate([ckpe, kpe], axis=1)

    o_f, s_f = _retention(rq, rk, rv, lw['ret_decay_fwd'], s_f0, strict=False)
    o_b, s_b = _retention(jnp.flip(rq, 1), jnp.flip(rk, 1), jnp.flip(rv, 1), lw['ret_decay_bwd'], s_b0, strict=True)
    o_ret = _group_layernorm(o_f + jnp.flip(o_b, 1)).reshape(B, S, BRANCH_W).astype(h.dtype)
    y_ret = jax.nn.silu(rg) * o_ret

    lq1, lk1, lq2, lk2 = lw['diff_lambda'][0], lw['diff_lambda'][1], lw['diff_lambda'][2], lw['diff_lambda'][3]
    lam = jnp.exp(jnp.sum(lq1 * lk1)) - jnp.exp(jnp.sum(lq2 * lk2)) + lam_init
    y_diff = _query_blocks(lambda q: _diff_attention(q, dk_all, dv_all, lam, lam_init), dq).reshape(B, S, BRANCH_W)

    kv = (ckv_all @ lw['w_ukv']).reshape(B, ckv_all.shape[1], H_MLA, MLA_NOPE + MLA_V)
    k_nope, v_mla = jnp.split(kv, [MLA_NOPE], axis=-1)
    y_mla = _query_blocks(lambda qn, qp: _mla_attention(qn, qp, k_nope, kpe_all, v_mla), q_nope, q_pe).reshape(B, S, BRANCH_W)

    branches = jnp.einsum('bsgc,gcd->bsgd', jnp.stack([y_ret, y_diff, y_mla], axis=2), lw['w_branch'])
    gates = jax.nn.sigmoid(gate_logits.reshape(B, S, N_BRANCH, D_MODEL))
    out = jnp.sum(gates * branches, axis=2) @ lw['w_out']
    ctx_out = None if ctx is not None else (s_f, s_b, dk.reshape(B, S, H_DIFF, 2 * DIFF_HD), dv, ckv, kpe)
    return out, ctx_out


def _layer(x, mod, lw, lam_init, rope, ctx):
    sh1, sc1, g1, sh2, sc2, g2 = jnp.split(mod, 6, axis=-1)
    h = _rmsnorm(x, lw['norm1_g']) * (1.0 + sc1) + sh1
    mix, ctx_out = _mixers(h, lw, lam_init, rope, ctx)
    x = x + g1 * mix
    h = _rmsnorm(x, lw['norm2_g']) * (1.0 + sc2) + sh2
    x = x + g2 * _swiglu(h, lw['w_ffn_in'], lw['w_ffn_out'])
    return x, ctx_out


def setup_inputs(seed: int = 0) -> dict:
    key = jax.random.key(seed)
    ks = jax.random.split(key, 32)
    f32 = jnp.float32

    def nrm(k, shape, scale):
        return jax.random.normal(k, shape, f32) * scale

    ret_init = jnp.log(jnp.exp2(5.0 + jnp.arange(H_RET, dtype=f32)) - 1.0)
    return {
        'x_prompt': nrm(ks[0], (BATCH, SEQ, D_MODEL), 1.0),
        'x_sample': nrm(ks[1], (DEC_BATCH, DEC_SEQ, D_MODEL), 1.0),
        'state_ret_fwd': nrm(ks[2], (DEC_BATCH, DEPTH, H_RET, RET_DK, RET_DV), 0.5),
        'state_ret_bwd': nrm(ks[3], (DEC_BATCH, DEPTH, H_RET, RET_DK, RET_DV), 0.5),
        'cache_diff_k': nrm(ks[4], (DEC_BATCH, DEPTH, PAST_LEN, H_DIFF, 2 * DIFF_HD), 1.0),
        'cache_diff_v': nrm(ks[5], (DEC_BATCH, DEPTH, PAST_LEN, H_DIFF, 2 * DIFF_HD), 1.0),
        'cache_mla_ckv': nrm(ks[6], (DEC_BATCH, DEPTH, PAST_LEN, KV_LORA), 1.0),
        'cache_mla_kpe': nrm(ks[7], (DEC_BATCH, DEPTH, PAST_LEN, MLA_ROPE), 1.0),
        'c': nrm(ks[8], (DEC_BATCH, D_MODEL), 1.0),
        'c_ctx': nrm(ks[9], (D_MODEL,), 1.0),
        'norm1_g': 1.0 + nrm(ks[10], (DEPTH, D_MODEL), 0.1),
        'norm2_g': 1.0 + nrm(ks[11], (DEPTH, D_MODEL), 0.1),
        'w_ada': nrm(ks[12], (DEPTH, D_MODEL, 6 * D_MODEL), 0.5 * D_MODEL ** -0.5),
        'b_ada': nrm(ks[13], (DEPTH, 6 * D_MODEL), 0.02),
        'w_in': nrm(ks[14], (DEPTH, D_MODEL, N_IN), D_MODEL ** -0.5),
        'ret_decay_fwd': ret_init[None, :] + nrm(ks[15], (DEPTH, H_RET), 0.1),
        'ret_decay_bwd': ret_init[None, :] + nrm(ks[16], (DEPTH, H_RET), 0.1),
        'diff_lambda': nrm(ks[17], (DEPTH, 4, DIFF_HD), 0.1),
        'mla_q_norm': 1.0 + nrm(ks[18], (DEPTH, Q_LORA), 0.1),
        'mla_kv_norm': 1.0 + nrm(ks[19], (DEPTH, KV_LORA), 0.1),
        'w_uq': nrm(ks[20], (DEPTH, Q_LORA, H_MLA * (MLA_NOPE + MLA_ROPE)), Q_LORA ** -0.5),
        'w_ukv': nrm(ks[21], (DEPTH, KV_LORA, H_MLA * (MLA_NOPE + MLA_V)), KV_LORA ** -0.5),
        'w_branch': nrm(ks[22], (DEPTH, N_BRANCH, BRANCH_W, D_MODEL), BRANCH_W ** -0.5),
        'w_out': nrm(ks[23], (DEPTH, D_MODEL, D_MODEL), D_MODEL ** -0.5),
        'w_ffn_in': nrm(ks[24], (DEPTH, D_MODEL, 2 * D_FF), D_MODEL ** -0.5),
        'w_ffn_out': nrm(ks[25], (DEPTH, D_FF, D_MODEL), D_FF ** -0.5),
        'final_g': 1.0 + nrm(ks[26], (D_MODEL,), 0.1),
    }


def reference(x_prompt, x_sample, state_ret_fwd, state_ret_bwd, cache_diff_k, cache_diff_v,
              cache_mla_ckv, cache_mla_kpe, c, c_ctx, norm1_g, norm2_g, w_ada, b_ada, w_in,
              ret_decay_fwd, ret_decay_bwd, diff_lambda, mla_q_norm, mla_kv_norm, w_uq, w_ukv,
              w_branch, w_out, w_ffn_in, w_ffn_out, final_g):
    rows = x_sample.shape[1] // GRID_W
    n_lat = rows * GRID_W
    rope = (_axial_rope_tables(n_lat, RET_DK), _axial_rope_tables(n_lat, MLA_ROPE))

    xp, xs = x_prompt, x_sample
    ret_f, ret_b, dks, dvs, ckvs, kpes = [], [], [], [], [], []
    for l in range(DEPTH):
        lw = {'norm1_g': norm1_g[l], 'norm2_g': norm2_g[l], 'w_in': w_in[l],
              'ret_decay_fwd': ret_decay_fwd[l], 'ret_decay_bwd': ret_decay_bwd[l],
              'diff_lambda': diff_lambda[l], 'mla_q_norm': mla_q_norm[l], 'mla_kv_norm': mla_kv_norm[l],
              'w_uq': w_uq[l], 'w_ukv': w_ukv[l], 'w_branch': w_branch[l], 'w_out': w_out[l],
              'w_ffn_in': w_ffn_in[l], 'w_ffn_out': w_ffn_out[l]}
        lam_init = 0.8 - 0.6 * math.exp(-0.3 * l)

        mod_ctx = _adaln(c_ctx[None, :], w_ada[l], b_ada[l])[:, None, :]
        xp, ctx_t = _layer(xp, mod_ctx, lw, lam_init, None, None)
        ret_f.append(ctx_t[0]); ret_b.append(ctx_t[1]); dks.append(ctx_t[2])
        dvs.append(ctx_t[3]); ckvs.append(ctx_t[4]); kpes.append(ctx_t[5])

        mod_lat = _adaln(c, w_ada[l], b_ada[l])[:, None, :]
        cache_l = (state_ret_fwd[:, l], state_ret_bwd[:, l], cache_diff_k[:, l], cache_diff_v[:, l],
                   cache_mla_ckv[:, l], cache_mla_kpe[:, l])
        xs, _ = _layer(xs, mod_lat, lw, lam_init, rope, cache_l)

    y_prompt = _rmsnorm(xp, final_g)
    y_sample = _rmsnorm(xs, final_g)
    new_ret_fwd = jnp.stack(ret_f, axis=1)
    new_ret_bwd = jnp.stack(ret_b, axis=1)
    new_diff_k = jnp.stack(dks, axis=1)
    new_diff_v = jnp.stack(dvs, axis=1)
    new_mla_ckv = jnp.stack(ckvs, axis=1)
    new_mla_kpe = jnp.stack(kpes, axis=1)
    return (y_prompt, y_sample, new_ret_fwd, new_ret_bwd, new_diff_k, new_diff_v, new_mla_ckv, new_mla_kpe)
```

```cpp
#include <hip/hip_runtime.h>
#include <hip/hip_cooperative_groups.h>
#include <cstdio>
#include <cstdint>
namespace cg = cooperative_groups;
#ifndef PROBE_E_REPS
#define PROBE_E_REPS 1
#endif
#ifndef PROBE_SYNC_REPS
#define PROBE_SYNC_REPS 1
#endif
#ifndef PROBE_EW_REPS
#define PROBE_EW_REPS 1
#endif
#ifndef PROBE_G1_REPS
#define PROBE_G1_REPS 1
#endif
#ifndef PROBE_G4_REPS
#define PROBE_G4_REPS 1
#endif
#ifndef PROBE_G6_REPS
#define PROBE_G6_REPS 1
#endif
#ifndef PROBE_C_REPS
#define PROBE_C_REPS 1
#endif
#ifndef PROBE_R_REPS
#define PROBE_R_REPS 1
#endif
#ifndef PROBE_D_REPS
#define PROBE_D_REPS 1
#endif
#ifndef PROBE_O_REPS
#define PROBE_O_REPS 1
#endif
#ifndef PROBE_MFMA
#define PROBE_MFMA 0
#endif
#ifndef PROBE_FA_MODE
#define PROBE_FA_MODE 0
#endif
namespace pg8 {
#define PG8_LAS __attribute__((address_space(3)))
typedef unsigned short bf16_t;
typedef short bf16x8 __attribute__((ext_vector_type(8)));
typedef float f32x4 __attribute__((ext_vector_type(4)));
typedef unsigned u32x4 __attribute__((ext_vector_type(4)));
constexpr int BM = 256, BK = 64, HALF = 128, HTB = HALF * BK * 2  , STAGE_BYTES = 8 * HTB, NXCD = 8, WGM = 8;

__host__ __device__ __forceinline__ int lds_byte(int r, int c) { const int st = (r >> 4) * 2 + (c >> 5), rr = r & 15, cc = c & 31, ob = rr * 64 + cc * 2; return st * 1024 + (ob ^ (((ob >> 9) & 1) << 5)); }
__host__ __device__ __forceinline__ void stage_rc(int b, int& R, int& C) { const int st = b / 1024, sb = b % 1024, swz = sb ^ (((sb >> 9) & 1) << 5); R = (st >> 1) * 16 + swz / 64; C = (st & 1) * 32 + (swz % 64) / 2; }
__host__ __device__ __forceinline__ int perm32(int rho) { const int n = rho >> 4, i = rho & 15; return 8 * (i >> 2) + 4 * n + (i & 3); }

struct Unit { int pm, pn; };
struct Gemm { const bf16_t* A; const bf16_t* Bt; int M, N, K; };

struct StaticOrder {
    int nM, nN, nwg, G, c;
    __host__ __device__ void init(int M, int N, int G_, int c_) { nM = M / BM; nN = N / BM; nwg = nM * nN; G = G_; c = c_; }
    __host__ __device__ bool next(int i, Unit& u) const {
        const long L = (long)i * G + c; if (L >= nwg) return false;
        int wgid = (int)L; { const int q = nwg / NXCD, r = nwg % NXCD, xcd = wgid % NXCD, off = wgid / NXCD; wgid = (xcd < r ? xcd * (q + 1) : r * (q + 1) + (xcd - r) * q) + off; }
        const int nig = WGM * nN, gid = wgid / nig, fm = gid * WGM, gsz = (nM - fm) < WGM ? (nM - fm) : WGM;
        u.pm = fm + ((wgid % nig) % gsz); u.pn = (wgid % nig) / gsz; return true;
    }
    __device__ __forceinline__ void a_ready(const Unit&) const {}
    __device__ __forceinline__ void done(const Unit&) const {}
};

typedef float f32x2c_t __attribute__((ext_vector_type(2))); typedef __bf16 bf16x2c_t __attribute__((ext_vector_type(2)));
__device__ __forceinline__ unsigned cvt_pk_bf16(float lo, float hi) { const f32x2c_t v = {lo, hi}; const bf16x2c_t b = __builtin_convertvector(v, bf16x2c_t); return __builtin_bit_cast(unsigned, b); }
typedef float f32x2 __attribute__((ext_vector_type(2)));
typedef unsigned u32x2 __attribute__((ext_vector_type(2)));
__device__ __forceinline__ float bf_lo(unsigned w) { return __uint_as_float(w << 16); }
__device__ __forceinline__ float bf_hi(unsigned w) { return __uint_as_float(w & 0xffff0000u); }
__device__ __forceinline__ float sigmoidf_(float x) { return __builtin_amdgcn_rcpf(1.0f + __expf(-x)); }
__device__ __forceinline__ float siluf_(float x) { return x * __builtin_amdgcn_rcpf(1.0f + __expf(-x)); }

struct EpiRaw {
    static constexpr bool PERM = true, AFTER_DRAIN = false;
    bf16_t* O; int ldc;
    __device__ __forceinline__ void operator()(const f32x4 (&acc)[2][2][4][2], const Unit& u, int wr, int wc, int fr, int fq) const {
        const int row0 = u.pm * BM + wr * 64 + fr, col0 = u.pn * BM + wc * 32 + 8 * fq;
#pragma unroll
        for (int ai = 0; ai < 2; ++ai)
#pragma unroll
            for (int m = 0; m < 4; ++m) { bf16_t* rowp = O + (size_t)(row0 + ai * HALF + m * 16) * ldc + col0;
#pragma unroll
                for (int bj = 0; bj < 2; ++bj) { const f32x4 v0 = acc[ai][bj][m][0], v1 = acc[ai][bj][m][1];
                    u32x4 w; w.x = cvt_pk_bf16(v0[0], v0[1]); w.y = cvt_pk_bf16(v0[2], v0[3]); w.z = cvt_pk_bf16(v1[0], v1[1]); w.w = cvt_pk_bf16(v1[2], v1[3]);
                    *(u32x4*)(rowp + bj * HALF) = w; } }
    }
};
struct EpiSwiglu {
    static constexpr bool PERM = true, AFTER_DRAIN = false;
    bf16_t* O; int ldc;
    __device__ __forceinline__ void operator()(const f32x4 (&acc)[2][2][4][2], const Unit& u, int wr, int wc, int fr, int fq) const {
        const int row0 = u.pm * BM + wr * 64 + fr, col0 = u.pn * HALF + wc * 32 + 8 * fq;
#pragma unroll
        for (int ai = 0; ai < 2; ++ai)
#pragma unroll
            for (int m = 0; m < 4; ++m) { bf16_t* rowp = O + (size_t)(row0 + ai * HALF + m * 16) * ldc + col0;
                float r[8];
#pragma unroll
                for (int n = 0; n < 2; ++n)
#pragma unroll
                    for (int e = 0; e < 4; ++e) r[n * 4 + e] = siluf_(acc[ai][0][m][n][e]) * acc[ai][1][m][n][e];
                u32x4 w; w.x = cvt_pk_bf16(r[0], r[1]); w.y = cvt_pk_bf16(r[2], r[3]); w.z = cvt_pk_bf16(r[4], r[5]); w.w = cvt_pk_bf16(r[6], r[7]);
                *(u32x4*)rowp = w; }
    }
};
struct EpiResid {
    static constexpr bool PERM = false, AFTER_DRAIN = false;
    const float* src0; const float* src1; float* out; const float* gate;
    int dry;
    __device__ __forceinline__ void operator()(const f32x4 (&acc)[2][2][4][2], const Unit& u, int wr, int wc, int fr, int fq) const {
        const int R0 = u.pm * BM; const int grp = R0 < 8192 ? 0 : 1 + ((R0 - 8192) >> 12);
        const float* src = R0 < 8192 ? src0 : src1; const float* gv = gate + grp * 6144;
        const int col0 = u.pn * BM + wc * 32 + 4 * fq;
        f32x4 gt[2][2];
#pragma unroll
        for (int bj = 0; bj < 2; ++bj)
#pragma unroll
            for (int n = 0; n < 2; ++n) gt[bj][n] = *(const f32x4*)(gv + col0 + bj * HALF + n * 16);
#pragma unroll
        for (int ai = 0; ai < 2; ++ai)
#pragma unroll
            for (int mp = 0; mp < 2; ++mp) { f32x4 b[2][2][2];
#pragma unroll
                for (int mm = 0; mm < 2; ++mm) { const size_t off = (size_t)(R0 + ai * HALF + wr * 64 + (2 * mp + mm) * 16 + fr) * 1024 + col0;
#pragma unroll
                    for (int bj = 0; bj < 2; ++bj)
#pragma unroll
                        for (int n = 0; n < 2; ++n) b[mm][bj][n] = *(const f32x4*)(src + off + bj * HALF + n * 16); }
#pragma unroll
                for (int mm = 0; mm < 2; ++mm) { const int m = 2 * mp + mm; const size_t off = (size_t)(R0 + ai * HALF + wr * 64 + m * 16 + fr) * 1024 + col0;
#pragma unroll
                    for (int bj = 0; bj < 2; ++bj)
#pragma unroll
                        for (int n = 0; n < 2; ++n) { if (!dry) *(f32x4*)(out + off + bj * HALF + n * 16) = b[mm][bj][n] + gt[bj][n] * acc[ai][bj][m][n]; } }
                asm volatile("" ::: "memory"); }
    }
};
struct EpiGate {
    static constexpr bool PERM = true, AFTER_DRAIN = false;
    const bf16_t* raw; bf16_t* brg; int MT;
    __device__ __forceinline__ void operator()(const f32x4 (&acc)[2][2][4][2], const Unit& u, int wr, int wc, int fr, int fq) const {
        const int g = u.pn >> 2, pn = u.pn & 3, pm = u.pm - g * MT;
        const int row0 = pm * BM + wr * 64 + fr, col0 = pn * BM + wc * 32 + 8 * fq;
        bf16_t* out = brg + (size_t)g * MT * BM * 1024;
#pragma unroll
        for (int ai = 0; ai < 2; ++ai) { u32x4 gwv[4][2];
#pragma unroll
            for (int m = 0; m < 4; ++m)
#pragma unroll
                for (int bj = 0; bj < 2; ++bj) gwv[m][bj] = *(const u32x4*)(raw + (size_t)(row0 + ai * HALF + m * 16) * 6912 + 3744 + g * 1024 + col0 + bj * HALF);
#pragma unroll
            for (int m = 0; m < 4; ++m) { const int row = row0 + ai * HALF + m * 16;
#pragma unroll
                for (int bj = 0; bj < 2; ++bj) { const int col = col0 + bj * HALF; const u32x4 gw = gwv[m][bj];
                    f32x4 v0 = acc[ai][bj][m][0], v1 = acc[ai][bj][m][1];
                    v0[0] *= sigmoidf_(bf_lo(gw.x)); v0[1] *= sigmoidf_(bf_hi(gw.x)); v0[2] *= sigmoidf_(bf_lo(gw.y)); v0[3] *= sigmoidf_(bf_hi(gw.y));
                    v1[0] *= sigmoidf_(bf_lo(gw.z)); v1[1] *= sigmoidf_(bf_hi(gw.z)); v1[2] *= sigmoidf_(bf_lo(gw.w)); v1[3] *= sigmoidf_(bf_hi(gw.w));
                    u32x4 w; w.x = cvt_pk_bf16(v0[0], v0[1]); w.y = cvt_pk_bf16(v0[2], v0[3]); w.z = cvt_pk_bf16(v1[0], v1[1]); w.w = cvt_pk_bf16(v1[2], v1[3]);
                    *(u32x4*)(out + (size_t)row * 1024 + col) = w; } }
            asm volatile("" ::: "memory"); }
    }
};
struct GateOrder {
    int MT, G, c;
    __device__ bool next(int i, Unit& u) const { const int L = i * G + c; if (L >= 3 * MT * 4) return false; const int g = L / (4 * MT), t = L % (4 * MT); u.pm = g * MT + (t >> 2); u.pn = g * 4 + (t & 3); return true; }
    __device__ __forceinline__ void a_ready(const Unit&) const {}
    __device__ __forceinline__ void done(const Unit&) const {}
};
struct OffsetOrder {
    StaticOrder S;
    __device__ void init(int M, int N, int G, int c, int off) { S.init(M, N, G, (c - off + G) % G); }
    __device__ bool next(int i, Unit& u) const { return S.next(i, u); }
    __device__ __forceinline__ void a_ready(const Unit&) const {}
    __device__ __forceinline__ void done(const Unit&) const {}
};
template <class Epi, class Sched, bool ALIGN_EPI = false, bool SP2 = false>
__device__ __forceinline__ void gemm_phase(PG8_LAS unsigned char* lds, const Gemm g, const Sched& S, const Epi& E) {
    int tid = threadIdx.x; asm volatile("" : "+v"(tid)); const int wid = __builtin_amdgcn_readfirstlane(tid >> 6), lane = tid & 63, wr = wid >> 2, wc = wid & 3, fr = lane & 15, fq = lane >> 4;
    const int K = g.K, nt = K / BK;
    unsigned voffA[2], voffB[2];
#pragma unroll
    for (int i = 0; i < 2; ++i) { int R, C; stage_rc(tid * 16 + i * 8192, R, C); const int Rb = Epi::PERM ? ((R & ~31) + perm32(R & 31)) : R;
        voffA[i] = (unsigned)(R * K + C) * 2u; voffB[i] = (unsigned)(Rb * K + C) * 2u; }
    const size_t kstep = (size_t)(BK * 2);
    const size_t hstep = (size_t)HALF * K * 2;
    const size_t tstep = 2 * hstep;
    const unsigned ldsw = (unsigned)wid * 1024u;
    const int aoff = lds_byte(wr * 64 + fr, fq * 8), boff = lds_byte(wc * 32 + fr, fq * 8);
#define PG8_SA(b, h) (((b) * 2 + (h)) * HTB)
#define PG8_SB(b, h) ((4 + (b) * 2 + (h)) * HTB)
#define PG8_STAGE(bufoff, gbase, voff) do { _Pragma("unroll") for (int _i = 0; _i < 2; ++_i) \
        __builtin_amdgcn_global_load_lds((const unsigned*)((const char*)(gbase) + (voff)[_i]), (PG8_LAS unsigned*)(lds + (bufoff) + ldsw + _i * 8192), 16, 0, 0); } while (0)
#define PG8_LDA(dst, b, h) do { _Pragma("unroll") for (int m = 0; m < 4; ++m) _Pragma("unroll") for (int k = 0; k < 2; ++k) dst[m][k] = *(const PG8_LAS bf16x8*)(lds + PG8_SA(b, h) + aoff + m * 2048 + k * 1024); } while (0)
#define PG8_LDB(dst, b, h) do { _Pragma("unroll") for (int n = 0; n < 2; ++n) _Pragma("unroll") for (int k = 0; k < 2; ++k) dst[n][k] = *(const PG8_LAS bf16x8*)(lds + PG8_SB(b, h) + boff + n * 2048 + k * 1024); } while (0)
#define PG8_MMA(ai, bj, At, Bt) do { __builtin_amdgcn_s_setprio(1); _Pragma("unroll") for (int m = 0; m < 4; ++m) _Pragma("unroll") for (int n = 0; n < 2; ++n) _Pragma("unroll") for (int k = 0; k < 2; ++k) \
        acc[ai][bj][m][n] = __builtin_amdgcn_mfma_f32_16x16x32_bf16(Bt[n][k], At[m][k], acc[ai][bj][m][n], 0, 0, 0); __builtin_amdgcn_s_setprio(0); } while (0)
#define PG8_WAIT_V(n) asm volatile("s_waitcnt vmcnt(" #n ")" ::: "memory")
#define PG8_WAIT_L(n) asm volatile("s_waitcnt lgkmcnt(" #n ")" ::: "memory")
#define PG8_BAR __builtin_amdgcn_s_barrier()
#define PG8_SCHED __builtin_amdgcn_sched_barrier(0)
    Unit cur, nxt; int ui = 0;
    if (!S.next(0, cur)) return;
    f32x4 acc[2][2][4][2];
#pragma unroll
    for (int a = 0; a < 2; ++a)
#pragma unroll
        for (int b = 0; b < 2; ++b)
#pragma unroll
            for (int m = 0; m < 4; ++m)
#pragma unroll
                for (int n = 0; n < 2; ++n) acc[a][b][m][n] = (f32x4){0.f, 0.f, 0.f, 0.f};
    bf16x8 At[4][2], B0[2][2], B1[2][2];
    const char* cA = (const char*)g.A + (size_t)cur.pm * tstep; const char* cB = (const char*)g.Bt + (size_t)cur.pn * tstep;
    S.a_ready(cur);
    if constexpr (SP2) {
        PG8_STAGE(PG8_SB(0, 0), cB, voffB); PG8_STAGE(PG8_SB(0, 1), cB + hstep, voffB); PG8_STAGE(PG8_SA(0, 0), cA, voffA); PG8_STAGE(PG8_SA(0, 1), cA + hstep, voffA);
        if (wr == 1) PG8_BAR;
        PG8_WAIT_V(2); PG8_BAR;
        PG8_STAGE(PG8_SB(1, 0), cB + kstep, voffB); PG8_STAGE(PG8_SA(1, 0), cA + kstep, voffA); PG8_STAGE(PG8_SB(1, 1), cB + hstep + kstep, voffB);
        PG8_WAIT_V(6); PG8_BAR;
    } else {
        PG8_STAGE(PG8_SB(0, 0), cB, voffB); PG8_STAGE(PG8_SA(0, 0), cA, voffA); PG8_STAGE(PG8_SB(0, 1), cB + hstep, voffB); PG8_STAGE(PG8_SA(0, 1), cA + hstep, voffA);
        if (wr == 1) PG8_BAR;
        PG8_WAIT_V(4); PG8_BAR;
        PG8_STAGE(PG8_SB(1, 0), cB + kstep, voffB); PG8_STAGE(PG8_SA(1, 0), cA + kstep, voffA); PG8_STAGE(PG8_SB(1, 1), cB + hstep + kstep, voffB);
        PG8_WAIT_V(6); PG8_BAR;
    }
    for (;;) {
        const bool has_next = S.next(ui + 1, nxt);
        const char* nA = has_next ? (const char*)g.A + (size_t)nxt.pm * tstep : cA; const char* nB = has_next ? (const char*)g.Bt + (size_t)nxt.pn * tstep : cB;
        for (int t = 0; t < nt; t += 2) {
            const bool last = (t == nt - 2);
            const char* a1 = cA + (size_t)(t + 1) * kstep;
            const char* a2 = last ? nA : cA + (size_t)(t + 2) * kstep; const char* b2 = last ? nB : cB + (size_t)(t + 2) * kstep;
            const char* a3 = a2 + kstep; const char* b3 = b2 + kstep;
            if (last && has_next) S.a_ready(nxt);
            if constexpr (SP2) {
            PG8_LDB(B0, 0, 0); PG8_LDB(B1, 0, 1); PG8_SCHED; PG8_LDA(At, 0, 0); PG8_STAGE(PG8_SA(1, 1), a1 + hstep, voffA);
            PG8_WAIT_V(8); PG8_WAIT_L(0); PG8_BAR; PG8_MMA(0, 0, At, B0); PG8_MMA(0, 1, At, B1); PG8_BAR; PG8_SCHED;
            PG8_LDA(At, 0, 1); PG8_STAGE(PG8_SB(0, 0), b2, voffB); PG8_STAGE(PG8_SB(0, 1), b2 + hstep, voffB); PG8_STAGE(PG8_SA(0, 0), a2, voffA);
            PG8_WAIT_V(8); PG8_WAIT_L(0); PG8_BAR; PG8_MMA(1, 0, At, B0); PG8_MMA(1, 1, At, B1); PG8_BAR; PG8_SCHED;
            PG8_LDB(B0, 1, 0); PG8_LDB(B1, 1, 1); PG8_SCHED; PG8_LDA(At, 1, 0); PG8_STAGE(PG8_SA(0, 1), a2 + hstep, voffA);
            PG8_WAIT_V(8); PG8_WAIT_L(0); PG8_BAR; PG8_MMA(0, 0, At, B0); PG8_MMA(0, 1, At, B1); PG8_BAR; PG8_SCHED;
            PG8_LDA(At, 1, 1); PG8_STAGE(PG8_SB(1, 0), b3, voffB); PG8_STAGE(PG8_SB(1, 1), b3 + hstep, voffB); PG8_STAGE(PG8_SA(1, 0), a3, voffA);
            PG8_WAIT_V(8); PG8_WAIT_L(0); PG8_BAR; PG8_MMA(1, 0, At, B0); PG8_MMA(1, 1, At, B1); PG8_BAR; PG8_SCHED;
            } else {
            PG8_LDB(B0, 0, 0); PG8_SCHED; PG8_LDA(At, 0, 0); PG8_STAGE(PG8_SA(1, 1), a1 + hstep, voffA);
            PG8_WAIT_L(8); PG8_BAR; PG8_WAIT_L(0); PG8_MMA(0, 0, At, B0); PG8_BAR; PG8_SCHED;
            PG8_LDB(B1, 0, 1); PG8_STAGE(PG8_SB(0, 0), b2, voffB);
            PG8_BAR; PG8_WAIT_L(0); PG8_MMA(0, 1, At, B1); PG8_BAR;
            PG8_LDA(At, 0, 1); PG8_STAGE(PG8_SA(0, 0), a2, voffA);
            PG8_BAR; PG8_WAIT_L(0); PG8_MMA(1, 0, At, B0); PG8_BAR; PG8_SCHED;
            PG8_STAGE(PG8_SB(0, 1), b2 + hstep, voffB);
            PG8_WAIT_V(6); PG8_BAR; PG8_MMA(1, 1, At, B1); PG8_BAR;
            PG8_LDB(B0, 1, 0); PG8_SCHED; PG8_LDA(At, 1, 0); PG8_STAGE(PG8_SA(0, 1), a2 + hstep, voffA);
            PG8_WAIT_L(8); PG8_BAR; PG8_WAIT_L(0); PG8_MMA(0, 0, At, B0); PG8_BAR; PG8_SCHED;
            PG8_LDB(B1, 1, 1); PG8_STAGE(PG8_SB(1, 0), b3, voffB);
            PG8_BAR; PG8_WAIT_L(0); PG8_MMA(0, 1, At, B1); PG8_BAR;
            PG8_LDA(At, 1, 1); PG8_STAGE(PG8_SA(1, 0), a3, voffA);
            PG8_BAR; PG8_WAIT_L(0); PG8_MMA(1, 0, At, B0); PG8_BAR; PG8_SCHED;
            PG8_STAGE(PG8_SB(1, 1), b3 + hstep, voffB);
            PG8_WAIT_V(6); PG8_BAR; PG8_MMA(1, 1, At, B1); PG8_BAR;
            }
        }
        if constexpr (ALIGN_EPI) { if (wr == 0) PG8_BAR; }
        if constexpr (!Epi::AFTER_DRAIN) { E(acc, cur, wr, wc, fr, fq); S.done(cur); }
        if (!has_next) break;
#pragma unroll
        for (int a = 0; a < 2; ++a)
#pragma unroll
            for (int b = 0; b < 2; ++b)
#pragma unroll
                for (int m = 0; m < 4; ++m)
#pragma unroll
                    for (int n = 0; n < 2; ++n) acc[a][b][m][n] = (f32x4){0.f, 0.f, 0.f, 0.f};
        cur = nxt; cA = nA; cB = nB; ++ui;
        if constexpr (ALIGN_EPI) { if (wr == 1) PG8_BAR; }
    }
    PG8_WAIT_V(0);
    if constexpr (!ALIGN_EPI) { if (wr == 0) PG8_BAR; }
    PG8_BAR;
    if constexpr (Epi::AFTER_DRAIN) { E.fused(acc, cur, wr, wc, fr, fq, lds, wid, lane); S.done(cur); }
#undef PG8_SA
#undef PG8_SB
#undef PG8_STAGE
#undef PG8_LDA
#undef PG8_LDB
#undef PG8_MMA
#undef PG8_WAIT_V
#undef PG8_WAIT_L
#undef PG8_BAR
#undef PG8_SCHED
}
}
#define LAS __attribute__((address_space(3)))
typedef unsigned short bf16_t;
typedef short bf16x8 __attribute__((ext_vector_type(8)));
typedef short s16x4 __attribute__((ext_vector_type(4)));
typedef float f32x4 __attribute__((ext_vector_type(4)));
typedef unsigned u32x4 __attribute__((ext_vector_type(4)));
using pg8::u32x2; using pg8::cvt_pk_bf16; using pg8::bf_lo; using pg8::bf_hi; using pg8::siluf_;
constexpr int NT = 512;
constexpr int DM = 1024, NTOK = 40960, NPR = 8192, NINP = 6912, CHR = 8192, NCOLA = 6144;
constexpr float EPSF = 1e-6f, L2E = 1.4426950408889634f;
constexpr size_t MiB = 1u << 20;
constexpr size_t WS_MOD = 0, WS_LAM = 512 * 1024, WS_ROPE = 1 * MiB, WS_W = 4 * MiB, WL_STRIDE = 37 * MiB;
constexpr size_t WO_IN = 0, WO_UQ = 13 * MiB + 512 * 1024, WO_UKV = 14 * MiB + 256 * 1024, WO_BR = 15 * MiB, WO_OUT = 18 * MiB, WO_FI = 20 * MiB, WO_FO = 31 * MiB;
constexpr size_t WS_ABUF = 78 * MiB, WS_RAW = 158 * MiB, WS_CQN = 266 * MiB, WS_CKVN = 272 * MiB, WS_KPE = 277 * MiB, WS_QMLA = 278 * MiB, WS_KVMLA = 290 * MiB,
                 WS_DKV = 308 * MiB, WS_ODIFF = 326 * MiB, WS_YALL = 358 * MiB, WS_U = 382 * MiB, WS_SIN = 398 * MiB, WS_HID = 158 * MiB, WS_BRG = 382 * MiB  , WS_END = 430 * MiB;
constexpr size_t OUT_YP = 0, OUT_RF = 41943040, OUT_RB = 44040192, OUT_DK = 46137344, OUT_DV = 54525952, OUT_CKV = 62914560, OUT_KPE = 67108864, OUT_TOTAL = 67633152;
constexpr int LDS_BYTES = 147456, MISC_OFF = 131072 + 320;
constexpr size_t WS_CTL = 3 * MiB;

__device__ __forceinline__ float bf2f(bf16_t v) { return __uint_as_float((unsigned)v << 16); }
__device__ __forceinline__ bf16_t f2bf(float f) { unsigned u = __float_as_uint(f); return (bf16_t)((u + 0x7fffu + ((u >> 16) & 1u)) >> 16); }
__device__ __forceinline__ float wave_sum(float v) {
#pragma unroll
    for (int o = 1; o < 64; o <<= 1) v += __shfl_xor(v, o);
    return v;
}
__device__ __forceinline__ s16x4 ds_tr(const LAS unsigned char* p) { return __builtin_bit_cast(s16x4, __builtin_amdgcn_ds_read_tr16_b64_v4i16((LAS s16x4*)p)); }
__device__ __forceinline__ bf16x8 tr2(const LAS unsigned char* p, int rowskip_bytes) { const s16x4 a = ds_tr(p), b = ds_tr(p + rowskip_bytes); return (bf16x8){a[0], a[1], a[2], a[3], b[0], b[1], b[2], b[3]}; }
__device__ __forceinline__ bf16x8 pack8(const f32x4 a, const f32x4 b) { u32x4 w; w.x = cvt_pk_bf16(a[0], a[1]); w.y = cvt_pk_bf16(a[2], a[3]); w.z = cvt_pk_bf16(b[0], b[1]); w.w = cvt_pk_bf16(b[2], b[3]); return __builtin_bit_cast(bf16x8, w); }
#define MFMA16(a, b, c) __builtin_amdgcn_mfma_f32_16x16x32_bf16((a), (b), (c), 0, 0, 0)

struct Params { const float* in[27]; float* out; unsigned char* ws; };

__device__ __forceinline__ void transpose_item(const float* W, int K, int N, bf16_t* WT, int k0, int n0, int dst_row0, LAS float* scr, int lane) {
#pragma unroll
    for (int i = 0; i < 32; ++i) { const int kk = 2 * i + (lane >> 5); scr[kk * 33 + (lane & 31)] = W[(size_t)(k0 + kk) * N + n0 + (lane & 31)]; }
    asm volatile("s_waitcnt lgkmcnt(0)" ::: "memory");
    const int c = lane & 7;
#pragma unroll
    for (int j = 0; j < 4; ++j) { const int n = (lane >> 3) + 8 * j; const LAS float* s = scr + (8 * c) * 33 + n;
        u32x4 o; o.x = cvt_pk_bf16(s[0 * 33], s[1 * 33]); o.y = cvt_pk_bf16(s[2 * 33], s[3 * 33]); o.z = cvt_pk_bf16(s[4 * 33], s[5 * 33]); o.w = cvt_pk_bf16(s[6 * 33], s[7 * 33]);
        *(u32x4*)(WT + (size_t)(dst_row0 + n) * K + k0 + 8 * c) = o; }
    asm volatile("s_waitcnt lgkmcnt(0)" ::: "memory");
}

__device__ __forceinline__ float xmax16(float v) { auto r = __builtin_amdgcn_permlane16_swap(__float_as_uint(v), __float_as_uint(v), false, false); return fmaxf(__uint_as_float(r[0]), __uint_as_float(r[1])); }
__device__ __forceinline__ float xmax32(float v) { auto r = __builtin_amdgcn_permlane32_swap(__float_as_uint(v), __float_as_uint(v), false, false); return fmaxf(__uint_as_float(r[0]), __uint_as_float(r[1])); }
__device__ __forceinline__ float xsum16(float v) { auto r = __builtin_amdgcn_permlane16_swap(__float_as_uint(v), __float_as_uint(v), false, false); return __uint_as_float(r[0]) + __uint_as_float(r[1]); }
__device__ __forceinline__ float xsum32(float v) { auto r = __builtin_amdgcn_permlane32_swap(__float_as_uint(v), __float_as_uint(v), false, false); return __uint_as_float(r[0]) + __uint_as_float(r[1]); }
__device__ __forceinline__ bf16x8 scale8(bf16x8 v, float sc) { const u32x4 w = __builtin_bit_cast(u32x4, v); u32x4 o;
    o.x = cvt_pk_bf16(bf_lo(w.x) * sc, bf_hi(w.x) * sc); o.y = cvt_pk_bf16(bf_lo(w.y) * sc, bf_hi(w.y) * sc); o.z = cvt_pk_bf16(bf_lo(w.z) * sc, bf_hi(w.z) * sc); o.w = cvt_pk_bf16(bf_lo(w.w) * sc, bf_hi(w.w) * sc);
    return __builtin_bit_cast(bf16x8, o); }
#define FA_BAR() do { asm volatile("s_waitcnt lgkmcnt(0)" ::: "memory"); __builtin_amdgcn_s_barrier(); asm volatile("" ::: "memory"); } while (0)
template <int DQK, int DV, bool OUT_BF16, bool TWO = false>
__device__ __forceinline__ void fa_unit(LAS unsigned char* lds, const bf16_t* __restrict__ Q, int qpitch, const bf16_t* __restrict__ K1, int k1pitch,
                                        const bf16_t* __restrict__ K2, int k2pitch, const bf16_t* __restrict__ V, int vpitch, int nkt, float sc, void* Out, int opitch, float lam = 0.f, float osc = 1.f, const float* rcos = nullptr, const float* rsin = nullptr, int pos0 = 0) {
    constexpr int KW = TWO ? 2 * DQK : DQK;
    constexpr int PK = KW + 8, VROW = DV * 2, KB = 64 * PK * 2, VB = 64 * VROW, STG = KB + VB;
    constexpr int KCH = KW / 8, VCH = DV / 8, NK = 64 * KCH, NV = 64 * VCH, KI = (NK + NT - 1) / NT, VI = (NV + NT - 1) / NT, NKS = DQK / 32, NET = DV / 16;
    static_assert(NV % NT == 0 && (NK % NT == 0 || NK - NT * (KI - 1) <= NT) && (NET == 4 || NET == 8), "staging piece counts");
    constexpr int EPP = 32 / (2 * NET);
    int tid = threadIdx.x; asm volatile("" : "+v"(tid)); const int lane = tid & 63, w = tid >> 6, g = lane >> 4, i16 = lane & 15;
    bf16x8 qf[2][NKS];
#pragma unroll
    for (int qt = 0; qt < 2; ++qt)
#pragma unroll
        for (int ks = 0; ks < NKS; ++ks) qf[qt][ks] = scale8(*(const bf16x8*)(Q + (size_t)(TWO ? 16 * w + i16 : 32 * w + 16 * qt + i16) * qpitch + (TWO ? DQK * qt : 0) + 32 * ks + 8 * g), sc);
    if (DQK == 96 && rcos != nullptr) {
#pragma unroll
        for (int qt = 0; qt < 2; ++qt) { const int pos = pos0 + 32 * w + 16 * qt + i16; const float* cp = rcos + (size_t)pos * 16 + 8 * (g & 1); const float* sp = rsin + (size_t)pos * 16 + 8 * (g & 1);
            const f32x4 c0 = *(const f32x4*)cp, c1 = *(const f32x4*)(cp + 4), s0 = *(const f32x4*)sp, s1 = *(const f32x4*)(sp + 4);
            const u32x4 me = __builtin_bit_cast(u32x4, qf[qt][NKS - 1]); u32x4 ot;
#pragma unroll
            for (int q = 0; q < 4; ++q) { const unsigned mw = q == 0 ? me.x : q == 1 ? me.y : q == 2 ? me.z : me.w;
                auto rr = __builtin_amdgcn_permlane32_swap(mw, mw, false, false); const unsigned pw = lane < 32 ? rr[1] : rr[0];
                const float cA = q < 2 ? c0[2 * q] : c1[2 * q - 4], cB = q < 2 ? c0[2 * q + 1] : c1[2 * q - 3], sA = q < 2 ? s0[2 * q] : s1[2 * q - 4], sB = q < 2 ? s0[2 * q + 1] : s1[2 * q - 3];
                const float sg = lane < 32 ? -1.0f : 1.0f;
                const float yA = bf_lo(mw) * cA + sg * bf_lo(pw) * sA, yB = bf_hi(mw) * cB + sg * bf_hi(pw) * sB;
                const unsigned ow = cvt_pk_bf16(yA, yB); if (q == 0) ot.x = ow; else if (q == 1) ot.y = ow; else if (q == 2) ot.z = ow; else ot.w = ow; }
            qf[qt][NKS - 1] = __builtin_bit_cast(bf16x8, ot); }
    }
    f32x4 o[NET][2];
#pragma unroll
    for (int et = 0; et < NET; ++et) { o[et][0] = (f32x4){0.f, 0.f, 0.f, 0.f}; o[et][1] = (f32x4){0.f, 0.f, 0.f, 0.f}; }
    f32x4 lacc[2] = {(f32x4){0.f, 0.f, 0.f, 0.f}, (f32x4){0.f, 0.f, 0.f, 0.f}};
    const bf16x8 ones = (bf16x8){0x3F80, 0x3F80, 0x3F80, 0x3F80, 0x3F80, 0x3F80, 0x3F80, 0x3F80};
    f32x4 negm[2] = {(f32x4){0.f, 0.f, 0.f, 0.f}, (f32x4){0.f, 0.f, 0.f, 0.f}};
    u32x4 kr0[KI], vr0[VI];
#define FA_IDXK(ii) ((tid + NT * (ii)) < NK ? (tid + NT * (ii)) : (tid + NT * (ii)) - NT)
#define FA_GLOADK(kt_, kreg) do { const int ktc_ = (kt_) < nkt ? (kt_) : nkt - 1; \
        _Pragma("unroll") for (int ii = 0; ii < KI; ++ii) { const int idx = FA_IDXK(ii); const int row = idx / KCH, ch = idx % KCH; \
            const bf16_t* src = (TWO || ch < 8) ? K1 + (size_t)(64 * ktc_ + row) * k1pitch + ch * 8 : K2 + (size_t)(64 * ktc_ + row) * k2pitch + (ch - 8) * 8; kreg[ii] = *(const u32x4*)src; } } while (0)
#define FA_GLOADV(vt_, vreg) do { const int vtc_ = (vt_) < nkt ? (vt_) : nkt - 1; \
        _Pragma("unroll") for (int ii = 0; ii < VI; ++ii) { const int idx = tid + NT * ii; const int row = idx / VCH, ch = idx % VCH; \
            vreg[ii] = *(const u32x4*)(V + (size_t)(64 * vtc_ + row) * vpitch + ch * 8); } } while (0)
#define FA_LWRITEK(stg, kreg) do { \
        _Pragma("unroll") for (int ii = 0; ii < KI; ++ii) { const int idx = FA_IDXK(ii); const int row = idx / KCH, ch = idx % KCH; *(LAS u32x4*)(lds + (stg) * STG + row * (PK * 2) + ch * 16) = kreg[ii]; } } while (0)
#define FA_LWRITEV(stg, vreg) do { \
        _Pragma("unroll") for (int ii = 0; ii < VI; ++ii) { const int idx = tid + NT * ii; const int row = idx / VCH, ch = idx % VCH; \
            const int fsw = (DV == 128) ? ((row & 3) | (((row >> 3) & 1) << 2)) : (((row >> 1) & 1) | (((row >> 3) & 1) << 1)); \
            *(LAS u32x4*)(lds + (stg) * STG + KB + row * VROW + ((((ch >> 1) ^ fsw)) << 5) + (ch & 1) * 16) = vreg[ii]; } } while (0)
#define FA_QK(stg) do { const LAS unsigned char* kb_ = lds + (stg) * STG; \
        _Pragma("unroll") for (int ks = 0; ks < NKS; ++ks) \
        _Pragma("unroll") for (int kt = 0; kt < 4; ++kt) { const int krow = 32 * (kt >> 1) + 8 * (i16 >> 2) + 4 * (kt & 1) + (i16 & 3); \
            const bf16x8 a = *(const LAS bf16x8*)(kb_ + krow * (PK * 2) + (32 * ks + 8 * g) * 2); \
            const bf16x8 a1 = TWO ? *(const LAS bf16x8*)(kb_ + krow * (PK * 2) + (DQK + 32 * ks + 8 * g) * 2) : a; \
            s[kt][0] = MFMA16(a, qf[0][ks], ks == 0 ? negm[0] : s[kt][0]); s[kt][1] = MFMA16(a1, qf[1][ks], ks == 0 ? negm[1] : s[kt][1]); } } while (0)
#define FA_MAXCHK(T) do { if (((T) < 2) || (((T) & 3) == 0)) { \
        _Pragma("unroll") for (int qt = 0; qt < 2; ++qt) { float mx = s[0][qt][0]; \
            _Pragma("unroll") for (int kt = 0; kt < 4; ++kt) _Pragma("unroll") for (int r = 0; r < 4; ++r) mx = fmaxf(mx, s[kt][qt][r]); \
            mx = xmax32(xmax16(mx)); const bool grow = ((T) == 0) || (mx > 8.0f); \
            if (__builtin_amdgcn_ballot_w64(grow)) { const float dl = grow ? mx : 0.f, al = __builtin_amdgcn_exp2f(-dl); lacc[qt] = lacc[qt] * al; \
                _Pragma("unroll") for (int kt = 0; kt < 4; ++kt) s[kt][qt] = s[kt][qt] - dl; \
                _Pragma("unroll") for (int et = 0; et < NET; ++et) o[et][qt] = o[et][qt] * al; \
                pf[0][qt] = scale8(pf[0][qt], al); pf[1][qt] = scale8(pf[1][qt], al);        \
                negm[qt] = negm[qt] - dl; } } } } while (0)
#define FA_EXP4(kt, qt) do { s[kt][qt][0] = __builtin_amdgcn_exp2f(s[kt][qt][0]); s[kt][qt][1] = __builtin_amdgcn_exp2f(s[kt][qt][1]); s[kt][qt][2] = __builtin_amdgcn_exp2f(s[kt][qt][2]); s[kt][qt][3] = __builtin_amdgcn_exp2f(s[kt][qt][3]); } while (0)
    const int vq = i16 >> 2; const int vsw = ((DV == 128) ? (vq | ((g & 1) << 2)) : (((vq >> 1) & 1) | ((g & 1) << 1))) << 5;
    f32x4 s[4][2];
    bf16x8 pf[2][2] = {{(bf16x8){0, 0, 0, 0, 0, 0, 0, 0}, (bf16x8){0, 0, 0, 0, 0, 0, 0, 0}}, {(bf16x8){0, 0, 0, 0, 0, 0, 0, 0}, (bf16x8){0, 0, 0, 0, 0, 0, 0, 0}}};
    FA_GLOADK(0, kr0); FA_LWRITEK(1, kr0);
    FA_GLOADK(1, kr0); FA_GLOADV(0, vr0); FA_LWRITEK(0, kr0); FA_LWRITEV(0, vr0);
    FA_GLOADK(2, kr0); FA_GLOADV(1, vr0);
    FA_BAR();
    FA_QK(1);
    FA_MAXCHK(0);
#pragma unroll
    for (int qt = 0; qt < 2; ++qt) {
#pragma unroll
        for (int kt = 0; kt < 4; ++kt) FA_EXP4(kt, qt);
        pf[0][qt] = pack8(s[0][qt], s[1][qt]); pf[1][qt] = pack8(s[2][qt], s[3][qt]); }
    FA_BAR();
#define FA_STEP(t, KR, VR) do { \
        const LAS unsigned char* vb = lds + ((t) & 1) * STG + KB; \
        bf16x8 va[NET]; \
        _Pragma("unroll") for (int et = 0; et < NET; ++et) va[et] = tr2(vb + (8 * g + vq) * VROW + ((et << 5) ^ vsw) + (lane & 3) * 8, 4 * VROW); \
        FA_LWRITEK(((t) + 1) & 1, KR); FA_LWRITEV(((t) + 1) & 1, VR);        \
        FA_GLOADK((t) + 3, KR); FA_GLOADV((t) + 2, VR);                        \
        FA_QK((t) & 1);                                                        \
        const bool more = (t) + 1 < nkt; \
        if (more) FA_MAXCHK((t) + 1); \
        __builtin_amdgcn_sched_barrier(0); \
        _Pragma("unroll") for (int j = 0; j < 2 * NET; ++j) {        \
            const int et = j % NET, sI = j / NET; \
            o[et][0] = MFMA16(va[et], pf[sI][0], o[et][0]); o[et][1] = MFMA16(va[et], pf[sI][1], o[et][1]); \
            if (sI == 0) va[et] = tr2(vb + (32 + 8 * g + vq) * VROW + ((et << 5) ^ vsw) + (lane & 3) * 8, 4 * VROW); \
            _Pragma("unroll") for (int e = 0; e < EPP; ++e) { const int v = j * EPP + e; s[(v & 15) >> 2][v >> 4][v & 3] = __builtin_amdgcn_exp2f(s[(v & 15) >> 2][v >> 4][v & 3]); } \
            if (j == NET - 1) { lacc[0] = MFMA16(ones, pf[0][0], lacc[0]); lacc[1] = MFMA16(ones, pf[0][1], lacc[1]); } \
            if (j == NET) pf[0][0] = pack8(s[0][0], s[1][0]);                \
            if (j == (NET == 8 ? 12 : 6)) pf[0][1] = pack8(s[0][1], s[1][1]); \
            __builtin_amdgcn_sched_barrier(0); } \
        lacc[0] = MFMA16(ones, pf[1][0], lacc[0]); lacc[1] = MFMA16(ones, pf[1][1], lacc[1]); \
        __builtin_amdgcn_sched_barrier(0); \
        pf[1][0] = pack8(s[2][0], s[3][0]); pf[1][1] = pack8(s[2][1], s[3][1]); \
        FA_BAR(); \
    } while (0)
    for (int t = 0; t < nkt; ++t) { FA_STEP(t, kr0, vr0); }
#undef FA_GLOADK
#undef FA_GLOADV
#undef FA_LWRITEK
#undef FA_LWRITEV
#undef FA_QK
#undef FA_STEP
#undef FA_MAXCHK
#undef FA_EXP4
    if (TWO) {
        const float i0 = 1.0f / lacc[0][0], i1 = lam / lacc[1][0]; float ss = 0.f;
#pragma unroll
        for (int et = 0; et < NET; ++et) { o[et][0] = o[et][0] * i0 - o[et][1] * i1; ss += (o[et][0][0] * o[et][0][0] + o[et][0][1] * o[et][0][1]) + (o[et][0][2] * o[et][0][2] + o[et][0][3] * o[et][0][3]); }
        ss = xsum32(xsum16(ss));
        const float scl = rsqrtf(ss * (1.0f / (float)DV) + EPSF) * osc; const size_t ro = (size_t)(16 * w + i16) * opitch;
#pragma unroll
        for (int et = 0; et < NET; ++et) { const f32x4 v = o[et][0] * scl; u32x2 pw; pw.x = cvt_pk_bf16(v[0], v[1]); pw.y = cvt_pk_bf16(v[2], v[3]); *(u32x2*)((bf16_t*)Out + ro + 16 * et + 4 * g) = pw; }
        return;
    }
#pragma unroll
    for (int qt = 0; qt < 2; ++qt) {
        const float lt = lacc[qt][0];
        const float inv = 1.0f / lt; const size_t ro = (size_t)(32 * w + 16 * qt + i16) * opitch;
#pragma unroll
        for (int et = 0; et < NET; ++et) { const f32x4 v = o[et][qt] * inv;
            if (OUT_BF16) { u32x2 pw; pw.x = cvt_pk_bf16(v[0], v[1]); pw.y = cvt_pk_bf16(v[2], v[3]); *(u32x2*)((bf16_t*)Out + ro + 16 * et + 4 * g) = pw; }
            else *(f32x4*)((float*)Out + ro + 16 * et + 4 * g) = v; }
    }
}
constexpr int RPK = 72 * 2, RPV = 136 * 2;
__device__ __forceinline__ void ret_local_unit(LAS unsigned char* lds, const bf16_t* __restrict__ raw, int cg, int h, float lf2, float lb2, float* __restrict__ U) {
    int tid = threadIdx.x; asm volatile("" : "+v"(tid)); const int lane = tid & 63, w = tid >> 6, g = lane >> 4, i16 = lane & 15;
    LAS unsigned char* Kf = lds; LAS unsigned char* Kb = lds + 128 * RPK; LAS unsigned char* Vl = lds + 2 * 128 * RPK;
    const bf16_t* base = raw + (size_t)cg * 128 * NINP;
#pragma unroll
    for (int ii = 0; ii < 2; ++ii) { const int idx = tid + NT * ii, row = idx >> 3, ch = idx & 7;
        const u32x4 kv = *(const u32x4*)(base + (size_t)row * NINP + 256 + h * 64 + ch * 8);
        const float zf = __builtin_amdgcn_exp2f((float)(127 - row) * lf2), zb = __builtin_amdgcn_exp2f((float)row * lb2);
        u32x4 a, b;
        a.x = cvt_pk_bf16(bf_lo(kv.x) * zf, bf_hi(kv.x) * zf); a.y = cvt_pk_bf16(bf_lo(kv.y) * zf, bf_hi(kv.y) * zf); a.z = cvt_pk_bf16(bf_lo(kv.z) * zf, bf_hi(kv.z) * zf); a.w = cvt_pk_bf16(bf_lo(kv.w) * zf, bf_hi(kv.w) * zf);
        b.x = cvt_pk_bf16(bf_lo(kv.x) * zb, bf_hi(kv.x) * zb); b.y = cvt_pk_bf16(bf_lo(kv.y) * zb, bf_hi(kv.y) * zb); b.z = cvt_pk_bf16(bf_lo(kv.z) * zb, bf_hi(kv.z) * zb); b.w = cvt_pk_bf16(bf_lo(kv.w) * zb, bf_hi(kv.w) * zb);
        *(LAS u32x4*)(Kf + row * RPK + ch * 16) = a; *(LAS u32x4*)(Kb + row * RPK + ch * 16) = b; }
#pragma unroll
    for (int ii = 0; ii < 4; ++ii) { const int idx = tid + NT * ii, row = idx >> 4, ch = idx & 15;
        *(LAS u32x4*)(Vl + row * RPV + ch * 16) = *(const u32x4*)(base + (size_t)row * NINP + 512 + h * 128 + ch * 8); }
    __syncthreads();
    f32x4 af[4], ab[4];
#pragma unroll
    for (int dt = 0; dt < 4; ++dt) { af[dt] = (f32x4){0.f, 0.f, 0.f, 0.f}; ab[dt] = (f32x4){0.f, 0.f, 0.f, 0.f}; }
#pragma unroll
    for (int s = 0; s < 4; ++s) { const int r0 = 32 * s + 8 * g + (i16 >> 2), c4 = 4 * (lane & 3);
        const bf16x8 a = tr2(Vl + r0 * RPV + (16 * w + c4) * 2, 4 * RPV);
#pragma unroll
        for (int dt = 0; dt < 4; ++dt) { const bf16x8 bf = tr2(Kf + r0 * RPK + (16 * dt + c4) * 2, 4 * RPK), bb = tr2(Kb + r0 * RPK + (16 * dt + c4) * 2, 4 * RPK);
            af[dt] = MFMA16(a, bf, af[dt]); ab[dt] = MFMA16(a, bb, ab[dt]); } }
    float* uf = U + ((size_t)(0 * 64 + cg) * 4 + h) * 8192; float* ub = U + ((size_t)(1 * 64 + cg) * 4 + h) * 8192;
#pragma unroll
    for (int dt = 0; dt < 4; ++dt) { const int off = (16 * dt + i16) * 128 + 16 * w + 4 * g; *(f32x4*)(uf + off) = af[dt]; *(f32x4*)(ub + off) = ab[dt]; }
    __syncthreads();
}
__device__ __forceinline__ void ret_out_unit(LAS unsigned char* lds, const bf16_t* __restrict__ raw, int cg, int h, float lf2, float lb2, const float* __restrict__ SIN, bf16_t* __restrict__ yret) {
    int tid = threadIdx.x; asm volatile("" : "+v"(tid)); const int lane = tid & 63, w = tid >> 6, g = lane >> 4, i16 = lane & 15;
    LAS unsigned char* Ql = lds; LAS unsigned char* Kl = lds + 128 * RPK; LAS unsigned char* Vl = lds + 2 * 128 * RPK; LAS unsigned char* Sfl = Vl + 128 * RPV; LAS unsigned char* Sbl = Sfl + 64 * RPV;
    const bf16_t* base = raw + (size_t)cg * 128 * NINP;
#pragma unroll
    for (int ii = 0; ii < 2; ++ii) { const int idx = tid + NT * ii, row = idx >> 3, ch = idx & 7;
        *(LAS u32x4*)(Ql + row * RPK + ch * 16) = *(const u32x4*)(base + (size_t)row * NINP + h * 64 + ch * 8);
        *(LAS u32x4*)(Kl + row * RPK + ch * 16) = *(const u32x4*)(base + (size_t)row * NINP + 256 + h * 64 + ch * 8); }
#pragma unroll
    for (int ii = 0; ii < 4; ++ii) { const int idx = tid + NT * ii, row = idx >> 4, ch = idx & 15;
        *(LAS u32x4*)(Vl + row * RPV + ch * 16) = *(const u32x4*)(base + (size_t)row * NINP + 512 + h * 128 + ch * 8); }
    const float* sf = SIN + ((size_t)(0 * 64 + cg) * 4 + h) * 8192; const float* sb = SIN + ((size_t)(1 * 64 + cg) * 4 + h) * 8192;
#pragma unroll
    for (int ii = 0; ii < 4; ++ii) { const int i4 = (tid + NT * ii) * 4, d = i4 >> 7, e = i4 & 127;
        const f32x4 a = *(const f32x4*)(sf + i4), b = *(const f32x4*)(sb + i4);
        u32x2 pa, pb; pa.x = cvt_pk_bf16(a[0], a[1]); pa.y = cvt_pk_bf16(a[2], a[3]); pb.x = cvt_pk_bf16(b[0], b[1]); pb.y = cvt_pk_bf16(b[2], b[3]);
        *(LAS u32x2*)(Sfl + d * RPV + e * 2) = pa; *(LAS u32x2*)(Sbl + d * RPV + e * 2) = pb; }
    __syncthreads();
    const int il = 16 * w + i16;
    bf16x8 qf[2];
#pragma unroll
    for (int ks = 0; ks < 2; ++ks) qf[ks] = *(const LAS bf16x8*)(Ql + il * RPK + (32 * ks + 8 * g) * 2);
    f32x4 o[8];
#pragma unroll
    for (int et = 0; et < 8; ++et) o[et] = (f32x4){0.f, 0.f, 0.f, 0.f};
    const int c4 = 4 * (lane & 3);
#pragma unroll
    for (int jb = 0; jb < 2; ++jb) {
        f32x4 st[4];
#pragma unroll
        for (int kt = 0; kt < 4; ++kt) st[kt] = (f32x4){0.f, 0.f, 0.f, 0.f};
#pragma unroll
        for (int ks = 0; ks < 2; ++ks)
#pragma unroll
            for (int kt = 0; kt < 4; ++kt) { const int krow = 64 * jb + 32 * (kt >> 1) + 8 * (i16 >> 2) + 4 * (kt & 1) + (i16 & 3);
                st[kt] = MFMA16(*(const LAS bf16x8*)(Kl + krow * RPK + (32 * ks + 8 * g) * 2), qf[ks], st[kt]); }
#pragma unroll
        for (int kt = 0; kt < 4; ++kt)
#pragma unroll
            for (int r = 0; r < 4; ++r) { const int j = 64 * jb + 32 * (kt >> 1) + 8 * g + 4 * (kt & 1) + r; const int df = il - j;
                const float wgt = df >= 0 ? __builtin_amdgcn_exp2f((float)df * lf2) : __builtin_amdgcn_exp2f((float)(-df) * lb2); st[kt][r] *= wgt; }
        const bf16x8 p0 = pack8(st[0], st[1]), p1 = pack8(st[2], st[3]);
#pragma unroll
        for (int et = 0; et < 8; ++et) {
            o[et] = MFMA16(tr2(Vl + (64 * jb + 8 * g + (i16 >> 2)) * RPV + (16 * et + c4) * 2, 4 * RPV), p0, o[et]);
            o[et] = MFMA16(tr2(Vl + (64 * jb + 32 + 8 * g + (i16 >> 2)) * RPV + (16 * et + c4) * 2, 4 * RPV), p1, o[et]); }
    }
    const float xif = __builtin_amdgcn_exp2f((float)(il + 1) * lf2), xib = __builtin_amdgcn_exp2f((float)(128 - il) * lb2);
#pragma unroll
    for (int et = 0; et < 8; ++et) {
        f32x4 tf = (f32x4){0.f, 0.f, 0.f, 0.f}, tb = (f32x4){0.f, 0.f, 0.f, 0.f};
#pragma unroll
        for (int ks = 0; ks < 2; ++ks) { const int r0 = 32 * ks + 8 * g + (i16 >> 2);
            tf = MFMA16(tr2(Sfl + r0 * RPV + (16 * et + c4) * 2, 4 * RPV), qf[ks], tf);
            tb = MFMA16(tr2(Sbl + r0 * RPV + (16 * et + c4) * 2, 4 * RPV), qf[ks], tb); }
        o[et] = o[et] + tf * xif + tb * xib;
    }
    float sm = 0.f;
#pragma unroll
    for (int et = 0; et < 8; ++et) sm += (o[et][0] + o[et][1]) + (o[et][2] + o[et][3]);
    sm += __shfl_xor(sm, 16); sm += __shfl_xor(sm, 32);
    const float mean = sm * (1.0f / 128.0f); float vs = 0.f;
#pragma unroll
    for (int et = 0; et < 8; ++et) { const f32x4 d = o[et] - mean; vs += (d[0] * d[0] + d[1] * d[1]) + (d[2] * d[2] + d[3] * d[3]); }
    vs += __shfl_xor(vs, 16); vs += __shfl_xor(vs, 32);
    const float rstd = rsqrtf(vs * (1.0f / 128.0f) + EPSF);
    const size_t row = (size_t)cg * 128 + il;
    u32x2 rgv[8];
#pragma unroll
    for (int et = 0; et < 8; ++et) rgv[et] = *(const u32x2*)(raw + row * NINP + 1024 + h * 128 + 16 * et + 4 * g);
#pragma unroll
    for (int et = 0; et < 8; ++et) { const int e = 16 * et + 4 * g;
        const u32x2 rg = rgv[et];
        const f32x4 y = (o[et] - mean) * rstd;
        u32x2 pw; pw.x = cvt_pk_bf16(siluf_(bf_lo(rg.x)) * y[0], siluf_(bf_hi(rg.x)) * y[1]); pw.y = cvt_pk_bf16(siluf_(bf_lo(rg.y)) * y[2], siluf_(bf_hi(rg.y)) * y[3]);
        *(u32x2*)(yret + row * 512 + h * 128 + e) = pw; }
    __syncthreads();
}
#define XB_TMO      128
#define XB_XCNT(j)  (256  + 64 * (j))
#define XB_XSUB(j)  (1280 + 64 * (j))
#define XB_XGEN(j)  (2304 + 64 * (j))
#define XB_TOP      3328
#define XB_TOPGEN   3392
#define XCD_BAR_WORDS 3456
#define XB_SPIN_CAP (1u << 18)

__device__ __forceinline__ unsigned xb_ld(unsigned* p)              { return __hip_atomic_load(p, __ATOMIC_RELAXED, __HIP_MEMORY_SCOPE_AGENT); }
__device__ __forceinline__ unsigned xb_add(unsigned* p, unsigned v) { return __hip_atomic_fetch_add(p, v, __ATOMIC_RELAXED, __HIP_MEMORY_SCOPE_AGENT); }
__device__ __forceinline__ unsigned xb_xcc_id() { return (unsigned)__builtin_amdgcn_s_getreg((3 << 11) | 20) & 0xFu; }
#define XB_SPIN(cond, bar) do { unsigned _sp = 0; while (cond) { __builtin_amdgcn_s_sleep(1); \
    if ((++_sp & 255u) == 0u) { if (xb_ld(&(bar)[XB_TMO])) break; if (_sp > XB_SPIN_CAP) { atomicAdd(&(bar)[XB_TMO], 1u); break; } } } } while (0)

struct XcdBarrier {
    unsigned* bar; unsigned x;
    volatile LAS unsigned* st;
};

__device__ __forceinline__ XcdBarrier xcd_barrier_post(unsigned* bar, volatile LAS unsigned* st) {
    XcdBarrier b; b.bar = bar; b.x = xb_xcc_id(); b.st = st;
    if (threadIdx.x == 0) (void)xb_add(&bar[XB_XCNT(b.x)], 1u);
    return b;
}
__device__ __forceinline__ void xcd_barrier_complete(unsigned* bar, unsigned x, unsigned& nloc, unsigned& nx) {
    const unsigned G = gridDim.x * gridDim.y * gridDim.z;
    unsigned sum, cnt, mine, sp = 0u;
    for (;;) {
        sum = 0u; cnt = 0u; mine = 0u;
#pragma unroll
        for (unsigned j = 0; j < 16; ++j) { const unsigned c = xb_ld(&bar[XB_XCNT(j)]); sum += c; cnt += (c > 0u) ? 1u : 0u; mine = (j == x) ? c : mine; }
        if (sum == G) break;
        __builtin_amdgcn_s_sleep(1);
        if ((++sp & 255u) == 0u) { if (xb_ld(&bar[XB_TMO])) break; if (sp > XB_SPIN_CAP) { atomicAdd(&bar[XB_TMO], 1u); break; } }
    }
    nloc = mine > 0u ? mine : 1u; nx = cnt > 0u ? cnt : 1u;
}

__device__ __forceinline__ void xcd_barrier(const XcdBarrier& b) {
    asm volatile("s_waitcnt vmcnt(0)" ::: "memory");
    __syncthreads();
    if (threadIdx.x == 0) {
        unsigned* bar = b.bar;
        __builtin_amdgcn_s_waitcnt(0);
        unsigned nloc = b.st[0], nx = b.st[1];
        if (nloc == 0u) { xcd_barrier_complete(bar, b.x, nloc, nx); b.st[0] = nloc; b.st[1] = nx; }
        const unsigned old = xb_add(&bar[XB_XSUB(b.x)], 1u);
        const unsigned gen = old / nloc;
        if (old + 1u == (gen + 1u) * nloc) {
            __builtin_amdgcn_fence(__ATOMIC_RELEASE, "agent");
            asm volatile("s_waitcnt vmcnt(0)" ::: "memory");
            const unsigned og = xb_add(&bar[XB_TOP], 1u);
            const unsigned tg = og / nx;
            if (og + 1u == (tg + 1u) * nx) xb_add(&bar[XB_TOPGEN], 1u);
            else XB_SPIN(xb_ld(&bar[XB_TOPGEN]) == tg, bar);
            __builtin_amdgcn_fence(__ATOMIC_ACQUIRE, "agent");
            xb_add(&bar[XB_XGEN(b.x)], 1u);
            asm volatile("s_waitcnt vmcnt(0)" ::: "memory");
        } else {
            XB_SPIN(xb_ld(&bar[XB_XGEN(b.x)]) == gen, bar);
            __builtin_amdgcn_fence(__ATOMIC_ACQUIRE, "agent");
            asm volatile("s_waitcnt vmcnt(0)" ::: "memory");
        }
    }
    __syncthreads();
}

typedef const __attribute__((address_space(4))) Params KParams;
#define ENV \
    int phv = ph; asm volatile("" : "+s"(phv)); \
    KParams* pk = (KParams*)__builtin_amdgcn_kernarg_segment_ptr(); asm volatile("" : "+s"(pk)); \
    int tid = threadIdx.x; asm volatile("" : "+v"(tid)); \
    const int lane = tid & 63, wave = __builtin_amdgcn_readfirstlane(tid >> 6); \
    int G = gridDim.x, bx = blockIdx.x; asm volatile("" : "+s"(G), "+s"(bx)); \
    const int vcu = (G % 8 == 0) ? (bx % 8) * (G / 8) + bx / 8 : bx; \
    const int gw = vcu * 8 + wave, NGW = G * 8; \
    unsigned char* ws = pk->ws; \
    float* modv = (float*)(ws + WS_MOD); float* lamv = (float*)(ws + WS_LAM); \
    float* cos64 = (float*)(ws + WS_ROPE); float* sin64 = cos64 + 4096 * 32; float* cos32 = sin64 + 4096 * 32; float* sin32 = cos32 + 4096 * 16; \
    bf16_t* ABUF = (bf16_t*)(ws + WS_ABUF); bf16_t* RAW = (bf16_t*)(ws + WS_RAW); bf16_t* CQN = (bf16_t*)(ws + WS_CQN); bf16_t* CKVN = (bf16_t*)(ws + WS_CKVN); \
    bf16_t* KPE = (bf16_t*)(ws + WS_KPE); bf16_t* QMLA = (bf16_t*)(ws + WS_QMLA); bf16_t* KVMLA = (bf16_t*)(ws + WS_KVMLA); bf16_t* DKV = (bf16_t*)(ws + WS_DKV); \
    float* ODIFF = (float*)(ws + WS_ODIFF); bf16_t* YALL = (bf16_t*)(ws + WS_YALL); float* UST = (float*)(ws + WS_U); float* SIN = (float*)(ws + WS_SIN); bf16_t* HID = (bf16_t*)(ws + WS_HID); bf16_t* BRG = (bf16_t*)(ws + WS_BRG); (void)BRG; \
    float* xres = pk->out + OUT_YP; \
    (void)lane; (void)gw; (void)NGW; (void)modv; (void)lamv; (void)cos64; (void)sin64; (void)cos32; (void)sin32; (void)ABUF; (void)RAW; (void)CQN; (void)CKVN; (void)KPE; (void)QMLA; (void)KVMLA; (void)DKV; \
    (void)ODIFF; (void)YALL; (void)UST; (void)SIN; (void)HID; (void)xres; (void)vcu;
#define LAYER_ENV \
    const int q_ = phv - 1, l = q_ / 36, rr_ = q_ % 36; (void)rr_; \
    unsigned char* wl = ws + WS_W + (size_t)l * WL_STRIDE; const float* modl = modv + l * 9 * 6144; \
    const float* xs0 = l == 0 ? pk->in[0] : xres; const float* xs1 = l == 0 ? pk->in[1] - (size_t)NPR * DM : xres; (void)wl; (void)modl; (void)xs0; (void)xs1;
#define CHUNK_ENV \
    const int ck = rr_ == 31 ? 4 : (rr_ - 1) / 6; const bool prompt = ck == 0; \
    const int row0 = ck * CHR, b0 = prompt ? 0 : 2 * (ck - 1), SEQL = prompt ? 256 : 4096, LK = prompt ? 256 : 4608, PAST = prompt ? 0 : 512, KVR = prompt ? 8192 : 9216, NCH = SEQL / 128, NQB = SEQL / 256; \
    (void)row0; (void)b0; (void)SEQL; (void)LK; (void)PAST; (void)KVR; (void)NCH; (void)NQB;
#define LGF(h) (lamv[8 + l * 8 + (h)])
#define LGB(h) (lamv[8 + l * 8 + 4 + (h)])

#define SUM3(a_, b_, c_) cvt_pk_bf16(bf_lo(a_) + bf_lo(b_) + bf_lo(c_), bf_hi(a_) + bf_hi(b_) + bf_hi(c_))
#define SUM_ROWS(w0_, wn_, dstrow0_) do { \
        for (int r = (w0_); r < CHR; r += (wn_)) { const size_t off = (size_t)r * 1024 + 8 * lane; \
            const u32x4 a0 = *(const u32x4*)(BRG + off), b0 = *(const u32x4*)(BRG + (size_t)CHR * 1024 + off), c0 = *(const u32x4*)(BRG + (size_t)2 * CHR * 1024 + off); \
            const u32x4 a1 = *(const u32x4*)(BRG + off + 512), b1 = *(const u32x4*)(BRG + (size_t)CHR * 1024 + off + 512), c1 = *(const u32x4*)(BRG + (size_t)2 * CHR * 1024 + off + 512); \
            u32x4 w0, w1; w0.x = SUM3(a0.x, b0.x, c0.x); w0.y = SUM3(a0.y, b0.y, c0.y); w0.z = SUM3(a0.z, b0.z, c0.z); w0.w = SUM3(a0.w, b0.w, c0.w); \
            w1.x = SUM3(a1.x, b1.x, c1.x); w1.y = SUM3(a1.y, b1.y, c1.y); w1.z = SUM3(a1.z, b1.z, c1.z); w1.w = SUM3(a1.w, b1.w, c1.w); \
            *(u32x4*)(ABUF + (size_t)(dstrow0_) * DM + off) = w0; *(u32x4*)(ABUF + (size_t)(dstrow0_) * DM + off + 512) = w1; } } while (0)
__global__ void __launch_bounds__(NT, 2) fwd_megakernel(Params p_unused) {
    extern __shared__ __attribute__((aligned(16))) unsigned char lds_raw[];
    LAS unsigned char* lds = (LAS unsigned char*)lds_raw;
    cg::grid_group grid = cg::this_grid();
    if (threadIdx.x < 32) ((volatile LAS unsigned*)(lds + MISC_OFF))[threadIdx.x] = 0u;
    __syncthreads();
    { KParams* pk0 = (KParams*)__builtin_amdgcn_kernarg_segment_ptr(); (void)xcd_barrier_post((unsigned*)(pk0->ws + WS_CTL), (volatile LAS unsigned*)(lds + MISC_OFF) + 8); }
    for (int ph = 0; ph < 74; ++ph) {
        int kind;
        if (ph == 0) kind = 0; else if (ph == 73) kind = 13; else { const int r = (ph - 1) % 36; const int ci = (r - 1) % 6; kind = r == 0 ? 1 : r <= 30 ? (ci == 5 ? 8 : 2 + ci) : r == 31 ? 14 : 9 + (r - 32); }
        if (kind == 0) { ENV
        for (int prb_ = 0; prb_ < PROBE_EW_REPS; ++prb_) {
        LAS float* sl = (LAS float*)lds; LAS float* red = (LAS float*)(lds + 40960);
        for (int blk = bx; blk < 192; blk += G) {
            const int l = blk / 96, n0 = (blk % 96) * 64;
            for (int i = tid; i < 9 * 1024; i += NT) { const int r = i >> 10, k = i & 1023; const float cv = r == 0 ? pk->in[9][k] : pk->in[8][(r - 1) * 1024 + k]; sl[i] = siluf_(cv); }
            __syncthreads();
            const int col = n0 + (tid & 63), ks = tid >> 6;
            float acc[9];
#pragma unroll
            for (int r = 0; r < 9; ++r) acc[r] = 0.f;
            const float* wa = pk->in[12] + (size_t)l * 1024 * 6144 + col;
#pragma unroll 16
            for (int k = ks * 128; k < ks * 128 + 128; ++k) { const float wv = wa[(size_t)k * 6144];
#pragma unroll
                for (int r = 0; r < 9; ++r) acc[r] += sl[r * 1024 + k] * wv; }
#pragma unroll
            for (int r = 0; r < 9; ++r) red[(ks * 9 + r) * 64 + (tid & 63)] = acc[r];
            __syncthreads();
            for (int i = tid; i < 9 * 64; i += NT) { const int r = i >> 6, cc = i & 63; float s = pk->in[13][l * 6144 + n0 + cc];
#pragma unroll
                for (int q = 0; q < 8; ++q) s += red[(q * 9 + r) * 64 + cc];
                modv[(l * 9 + r) * 6144 + n0 + cc] = s; }
            __syncthreads();
        }
        if (bx == 0 && tid < 2) { const int l = tid; const float* dl = pk->in[17] + l * 256; float s1 = 0.f, s2 = 0.f;
            for (int i = 0; i < 64; ++i) { s1 += dl[i] * dl[64 + i]; s2 += dl[128 + i] * dl[192 + i]; }
            const float li = l == 0 ? 0.2f : 0.8f - 0.6f * 0.74081822068171786f;
            lamv[l] = __expf(s1) - __expf(s2) + li; lamv[2 + l] = li;
            float df[4], db[4];
            for (int h = 0; h < 4; ++h) { df[h] = pk->in[15][l * 4 + h]; db[h] = pk->in[16][l * 4 + h]; }
            for (int h = 0; h < 4; ++h) { lamv[8 + l * 8 + h] = -__logf(1.0f + __expf(-df[h])) * L2E; lamv[8 + l * 8 + 4 + h] = -__logf(1.0f + __expf(-db[h])) * L2E; } }
        for (int i = bx * NT + tid; i < 4096 * 48; i += G * NT) {
            int pos, dd, nf; float* cd; float* sd;
            if (i < 4096 * 32) { pos = i >> 5; dd = i & 31; nf = 16; cd = cos64 + i; sd = sin64 + i; } else { const int j = i - 4096 * 32; pos = j >> 4; dd = j & 15; nf = 8; cd = cos32 + j; sd = sin32 + j; }
            const int f = dd % nf; const float basev = dd < nf ? (float)(pos >> 6) : (float)(pos & 63);
            const float inv = __builtin_amdgcn_exp2f(-(float)f / (float)nf * 13.287712379549449f);
            const float ang = basev * inv; const float kq = rintf(ang * 0.15915494309189535f);
            float r = fmaf(-kq, 6.28125f, ang); r = fmaf(-kq, 1.9353071795864769e-3f, r);
            *cd = __cosf(r); *sd = __sinf(r);
        }
        __syncthreads();
        LAS float* scr = (LAS float*)(lds + wave * 16384);
        constexpr int I_IN = 16 * 213, I_UQ = 6 * 24, I_UKV = 4 * 32, I_BR = 8 * 32, I_OUT = 16 * 32, I_FI = 16 * 176, I_FO = 44 * 32;
        constexpr int I_L = I_IN + I_UQ + I_UKV + 3 * I_BR + I_OUT + I_FI + I_FO;
        for (int it = gw; it < 2 * I_L; it += NGW) {
            const int l = it / I_L; int r = it % I_L; unsigned char* wl = ws + WS_W + (size_t)l * WL_STRIDE;
            if (r < I_IN) { const int kb = r / 213, nb = r % 213; transpose_item(pk->in[14] + (size_t)l * 1024 * 6816, 1024, 6816, (bf16_t*)(wl + WO_IN), 64 * kb, 32 * nb, 32 * nb, scr, lane); continue; } r -= I_IN;
            if (r < I_UQ) { const int kb = r / 24, nb = r % 24; transpose_item(pk->in[20] + (size_t)l * 384 * 768, 384, 768, (bf16_t*)(wl + WO_UQ), 64 * kb, 32 * nb, 32 * nb, scr, lane); continue; } r -= I_UQ;
            if (r < I_UKV) { const int kb = r / 32, nb = r % 32; transpose_item(pk->in[21] + (size_t)l * 256 * 1024, 256, 1024, (bf16_t*)(wl + WO_UKV), 64 * kb, 32 * nb, 32 * nb, scr, lane); continue; } r -= I_UKV;
            if (r < 3 * I_BR) { const int gg = r / I_BR, rr = r % I_BR, kb = rr / 32, nb = rr % 32;
                transpose_item(pk->in[22] + ((size_t)l * 3 + gg) * 512 * 1024, 512, 1024, (bf16_t*)(wl + WO_BR), 64 * kb, 32 * nb, gg * 1024 + 32 * nb, scr, lane); continue; } r -= 3 * I_BR;
            if (r < I_OUT) { const int kb = r / 32, nb = r % 32; transpose_item(pk->in[23] + (size_t)l * 1024 * 1024, 1024, 1024, (bf16_t*)(wl + WO_OUT), 64 * kb, 32 * nb, 32 * nb, scr, lane); continue; } r -= I_OUT;
            if (r < I_FI) { const int kb = r / 176, nb = r % 176; const int n0 = 32 * nb; const int dst = n0 < 2816 ? 256 * (n0 / 128) + (n0 % 128) : 256 * ((n0 - 2816) / 128) + 128 + ((n0 - 2816) % 128);
                transpose_item(pk->in[24] + (size_t)l * 1024 * 5632, 1024, 5632, (bf16_t*)(wl + WO_FI), 64 * kb, n0, dst, scr, lane); continue; } r -= I_FI;
            { const int kb = r / 32, nb = r % 32; transpose_item(pk->in[25] + (size_t)l * 2816 * 1024, 2816, 1024, (bf16_t*)(wl + WO_FO), 64 * kb, 32 * nb, 32 * nb, scr, lane); }
        }
        __syncthreads(); }
        }
        else if (kind == 1) { ENV LAYER_ENV
        for (int prb_ = 0; prb_ < PROBE_EW_REPS; ++prb_)
        for (int m = gw; m < NTOK; m += NGW) {
            const int grp = m < NPR ? 0 : 1 + ((m - NPR) >> 12); const float* xr = (m < NPR ? xs0 : xs1) + (size_t)m * DM; const float* md = modl + grp * 6144; const float* gn = pk->in[10] + l * DM;
            f32x4 v[4]; float ss = 0.f;
#pragma unroll
            for (int j = 0; j < 4; ++j) { v[j] = *(const f32x4*)(xr + 4 * lane + 256 * j); ss += (v[j][0] * v[j][0] + v[j][1] * v[j][1]) + (v[j][2] * v[j][2] + v[j][3] * v[j][3]); }
            const float rstd = rsqrtf(wave_sum(ss) * (1.0f / DM) + EPSF);
#pragma unroll
            for (int j = 0; j < 4; ++j) { const int c = 4 * lane + 256 * j; const f32x4 gg = *(const f32x4*)(gn + c), sh = *(const f32x4*)(md + c), scv = *(const f32x4*)(md + 1024 + c);
                const f32x4 y = v[j] * rstd * gg * (scv + 1.0f) + sh; u32x2 pw; pw.x = cvt_pk_bf16(y[0], y[1]); pw.y = cvt_pk_bf16(y[2], y[3]);
                *(u32x2*)(ABUF + (size_t)m * DM + c) = pw; }
        } }
        else if (kind == 2) { ENV LAYER_ENV CHUNK_ENV
            for (int prg_ = 0; prg_ < PROBE_G1_REPS; ++prg_)
            { pg8::Gemm g{ABUF + (size_t)row0 * DM, (const bf16_t*)(wl + WO_IN), CHR, NCOLA, DM}; pg8::StaticOrder S; S.init(CHR, NCOLA, G, bx); pg8::EpiRaw E{RAW, NINP};

          pg8::gemm_phase<pg8::EpiRaw, pg8::StaticOrder, true, true>(lds, g, S, E);
 }
        }
        else if (kind == 3) { ENV LAYER_ENV CHUNK_ENV
            { pg8::Gemm g{ABUF + (size_t)row0 * DM, (const bf16_t*)(wl + WO_IN) + (size_t)NCOLA * DM, CHR, NINP - NCOLA, DM}; pg8::StaticOrder S; S.init(CHR, NINP - NCOLA, G, bx); pg8::EpiRaw E{RAW + NCOLA, NINP};
              pg8::gemm_phase<pg8::EpiRaw, pg8::StaticOrder, true, true>(lds, g, S, E); }
            const int nun = (CHR / 256) * ((NINP - NCOLA) / 256); const bool split = nun < G;
            const int pw0 = split ? (bx - nun) * 8 + wave : gw, pwn = split ? (G - nun) * 8 : NGW;
            if (!split || bx >= nun) {
            for (int r = pw0; r < CHR + (prompt ? 0 : 1024); r += pwn) {
                if (r < CHR) {
                    bf16_t* rp = RAW + (size_t)r * NINP; const int bb = r / SEQL, s = r % SEQL; const size_t kvrow = (size_t)bb * LK + PAST + s; const size_t orow = ((size_t)bb * 2 + l) * 256 + s;
                    const int dd = lane & 31, hq = lane >> 5;
                    float ra[8], rb[8], ka[4], kb[4], cqv[6], ckvv[4];
#pragma unroll
                    for (int i = 0; i < 8; ++i) { const int head = 2 * i + hq; const int cb = head < 8 ? head * 64 : 1536 + (head - 8) * 64; ra[i] = bf2f(rp[cb + dd]); rb[i] = bf2f(rp[cb + dd + 32]); }
#pragma unroll
                    for (int i = 0; i < 4; ++i) { const int cb = 2048 + (2 * i + hq) * 64; ka[i] = bf2f(rp[cb + dd]); kb[i] = bf2f(rp[cb + dd + 32]); }
                    const u32x4 dv = *(const u32x4*)(rp + 2560 + 8 * lane);
#pragma unroll
                    for (int i = 0; i < 6; ++i) cqv[i] = bf2f(rp[3072 + lane + 64 * i]);
#pragma unroll
                    for (int i = 0; i < 4; ++i) ckvv[i] = bf2f(rp[3456 + lane + 64 * i]);
                    float p1 = bf2f(rp[3712 + (lane & 15)]), p2 = bf2f(rp[3712 + 16 + (lane & 15)]);
                    float c6 = 1.f, s6 = 0.f, c3 = 1.f, s3 = 0.f;
                    if (!prompt) { c6 = cos64[s * 32 + dd]; s6 = sin64[s * 32 + dd]; c3 = cos32[s * 16 + (lane & 15)]; s3 = sin32[s * 16 + (lane & 15)]; }
                    float gq[6], gk[4];
#pragma unroll
                    for (int i = 0; i < 6; ++i) gq[i] = pk->in[18][l * 384 + lane + 64 * i];
#pragma unroll
                    for (int i = 0; i < 4; ++i) gk[i] = pk->in[19][l * 256 + lane + 64 * i];
                    float ssq = 0.f, ssk = 0.f;
#pragma unroll
                    for (int i = 0; i < 6; ++i) ssq += cqv[i] * cqv[i];
#pragma unroll
                    for (int i = 0; i < 4; ++i) ssk += ckvv[i] * ckvv[i];
                    const float rsq = rsqrtf(wave_sum(ssq) * (1.0f / 384.0f) + EPSF), rsk = rsqrtf(wave_sum(ssk) * (1.0f / 256.0f) + EPSF);
#pragma unroll
                    for (int i = 0; i < 8; ++i) { const int head = 2 * i + hq; const int cb = head < 8 ? head * 64 : 1536 + (head - 8) * 64; const float sc = (head >= 4 && head < 8) ? 0.125f : 1.0f;
                        const float x1 = ra[i] * sc, x2 = rb[i] * sc; rp[cb + dd] = f2bf(x1 * c6 - x2 * s6); rp[cb + dd + 32] = f2bf(x2 * c6 + x1 * s6); }
#pragma unroll
                    for (int i = 0; i < 4; ++i) { const int head = 2 * i + hq;
                        if (prompt) { float* od = pk->out + OUT_DK + orow * 512 + head * 64 + dd; od[0] = ka[i]; od[32] = kb[i]; }
                        DKV[kvrow * 1024 + head * 64 + dd] = f2bf(ka[i] * c6 - kb[i] * s6); DKV[kvrow * 1024 + head * 64 + dd + 32] = f2bf(kb[i] * c6 + ka[i] * s6); }
                    *(u32x4*)(DKV + kvrow * 1024 + 512 + 8 * lane) = dv;
                    if (prompt) { float* od = pk->out + OUT_DV + orow * 512 + 8 * lane; *(f32x4*)od = (f32x4){bf_lo(dv.x), bf_hi(dv.x), bf_lo(dv.y), bf_hi(dv.y)}; *(f32x4*)(od + 4) = (f32x4){bf_lo(dv.z), bf_hi(dv.z), bf_lo(dv.w), bf_hi(dv.w)}; }
#pragma unroll
                    for (int i = 0; i < 6; ++i) CQN[(size_t)r * 384 + lane + 64 * i] = f2bf(cqv[i] * rsq * gq[i]);
#pragma unroll
                    for (int i = 0; i < 4; ++i) { const float y = ckvv[i] * rsk * gk[i]; CKVN[kvrow * 256 + lane + 64 * i] = f2bf(y); if (prompt) pk->out[OUT_CKV + orow * 256 + lane + 64 * i] = y; }
                    if (lane < 16) {
                        if (prompt) { pk->out[OUT_KPE + orow * 32 + lane] = p1; pk->out[OUT_KPE + orow * 32 + 16 + lane] = p2; }
                        KPE[kvrow * 32 + lane] = f2bf(p1 * c3 - p2 * s3); KPE[kvrow * 32 + 16 + lane] = f2bf(p2 * c3 + p1 * s3); }
                } else {
                    const int cr = r - CHR, bb = cr >> 9, key = cr & 511; const size_t kvrow = (size_t)bb * LK + key; const size_t crow = ((size_t)(b0 + bb) * 2 + l) * 512 + key;
                    { const float* s0 = pk->in[4] + crow * 512 + 8 * lane; const float* s1 = pk->in[5] + crow * 512 + 8 * lane;
                      const f32x4 a = *(const f32x4*)s0, b = *(const f32x4*)(s0 + 4), c = *(const f32x4*)s1, d = *(const f32x4*)(s1 + 4), e = *(const f32x4*)(pk->in[6] + crow * 256 + 4 * lane);
                      const float kp = pk->in[7][crow * 32 + (lane & 31)];
                      u32x4 w; w.x = cvt_pk_bf16(a[0], a[1]); w.y = cvt_pk_bf16(a[2], a[3]); w.z = cvt_pk_bf16(b[0], b[1]); w.w = cvt_pk_bf16(b[2], b[3]); *(u32x4*)(DKV + kvrow * 1024 + 8 * lane) = w;
                      w.x = cvt_pk_bf16(c[0], c[1]); w.y = cvt_pk_bf16(c[2], c[3]); w.z = cvt_pk_bf16(d[0], d[1]); w.w = cvt_pk_bf16(d[2], d[3]); *(u32x4*)(DKV + kvrow * 1024 + 512 + 8 * lane) = w;
                      u32x2 w2; w2.x = cvt_pk_bf16(e[0], e[1]); w2.y = cvt_pk_bf16(e[2], e[3]); *(u32x2*)(CKVN + kvrow * 256 + 4 * lane) = w2;
                      if (lane < 32) KPE[kvrow * 32 + lane] = f2bf(kp); }
                }
            }
            if (ck > 0) { SUM_ROWS(pw0, pwn, row0 - CHR); }
            } }
        else if (kind == 4) { ENV LAYER_ENV CHUNK_ENV
            for (int prc_ = 0; prc_ < PROBE_C_REPS; ++prc_) {
            { pg8::Gemm g{CQN, (const bf16_t*)(wl + WO_UQ), CHR, 768, 384}; pg8::OffsetOrder S; S.init(CHR, 768, G, bx, 0); pg8::EpiRaw E{QMLA, 768};

          pg8::gemm_phase<pg8::EpiRaw, pg8::OffsetOrder, true, true>(lds, g, S, E);
 }
            { pg8::Gemm g{CKVN, (const bf16_t*)(wl + WO_UKV), KVR, 1024, 256}; pg8::OffsetOrder S; S.init(KVR, 1024, G, bx, 96 % G); pg8::EpiRaw E{KVMLA, 1024};

          pg8::gemm_phase<pg8::EpiRaw, pg8::OffsetOrder, true, true>(lds, g, S, E);
 }
            for (int u = (bx + G - (240 % G)) % G; u < 256; u += G) { const int h = u & 3;
ret_local_unit(lds, RAW, u >> 2, h, LGF(h), LGB(h), UST);
 }
            }
        }
        else if (kind == 5) { ENV LAYER_ENV CHUNK_ENV
            { const int nbat = prompt ? 32 : 2; const int total = nbat * 8 * 8192;
              for (int prb_ = 0; prb_ < PROBE_EW_REPS; ++prb_)
              for (int i = bx * NT + tid; i < total; i += G * NT) { const int e = i & 8191, rest = i >> 13, dir = rest & 1, h = (rest >> 1) & 3, bb = rest >> 3;
                  const float gC = __builtin_amdgcn_exp2f(128.0f * (dir == 0 ? LGF(h) : LGB(h)));
                  const size_t so = (((size_t)(b0 + bb) * 2 + l) * 4 + h) * 8192 + e;
                  float s = prompt ? 0.f : (dir == 0 ? pk->in[2][so] : pk->in[3][so]);
                  if (NCH >= 8) {
                      for (int c0 = 0; c0 < NCH; c0 += 8) { float uu[8]; size_t uo[8];
#pragma unroll
                          for (int k = 0; k < 8; ++k) { const int cc = c0 + k; const int c = dir == 0 ? cc : NCH - 1 - cc; uo[k] = ((size_t)(dir * 64 + bb * NCH + c) * 4 + h) * 8192 + e; uu[k] = UST[uo[k]]; }
#pragma unroll
                          for (int k = 0; k < 8; ++k) { SIN[uo[k]] = s; s = gC * s + uu[k]; } }
                  } else {
                      for (int c0 = 0; c0 < NCH; c0 += 2) { float uu[2]; size_t uo[2];
#pragma unroll
                          for (int k = 0; k < 2; ++k) { const int cc = c0 + k; const int c = dir == 0 ? cc : NCH - 1 - cc; uo[k] = ((size_t)(dir * 64 + bb * NCH + c) * 4 + h) * 8192 + e; uu[k] = UST[uo[k]]; }
#pragma unroll
                          for (int k = 0; k < 2; ++k) { SIN[uo[k]] = s; s = gC * s + uu[k]; } }
                  }
                  if (prompt) pk->out[(dir == 0 ? OUT_RF : OUT_RB) + so] = s; } } }
        else if (kind == 6) { ENV LAYER_ENV CHUNK_ENV
            for (int rep_ = 0; rep_ < PROBE_E_REPS; ++rep_) {
#if PROBE_FA_MODE
            if (!prompt) for (int u = vcu; u < 256; u += G) { const int qb = u % NQB, c = (u / NQB) & 1, h = (u / (2 * NQB)) & 3, bb = u / (8 * NQB); const size_t qrow = (size_t)bb * SEQL + qb * 256;
                fa_unit<64, 128, false, PROBE_FA_MODE>(lds, RAW + qrow * NINP + 1536 + h * 128 + c * 64, NINP, DKV + (size_t)bb * LK * 1024 + h * 128 + c * 64, 1024, nullptr, 0,
                                        DKV + (size_t)bb * LK * 1024 + 512 + h * 128, 1024, LK / 64, 0.125f * L2E, (float*)(ws + 432 * MiB) + ((size_t)c * CHR + qrow) * 512 + h * 128, 512); }
#endif
            { const float lam = lamv[l], lam_init = lamv[2 + l]; const int NQ2 = SEQL / 128;
            for (int u = vcu; u < 256; u += G) { const int qb = u % NQ2, h = (u / NQ2) & 3, bb = u / (4 * NQ2); const size_t qrow = (size_t)bb * SEQL + qb * 128;
                fa_unit<64, 128, true, true>(lds, RAW + qrow * NINP + 1536 + h * 128, NINP, DKV + (size_t)bb * LK * 1024 + h * 128, 1024, nullptr, 0,
                                             DKV + (size_t)bb * LK * 1024 + 512 + h * 128, 1024, LK / 64, 0.125f * L2E, YALL + ((size_t)CHR + qrow) * 512 + h * 128, 512, lam, 1.0f - lam_init); } }
            for (int u = vcu; u < 256; u += G) { const int qb = u % NQB, h = (u / NQB) & 7, bb = u / (8 * NQB); const size_t qrow = (size_t)bb * SEQL + qb * 256;
                fa_unit<96, 64, true>(lds, QMLA + qrow * 768 + h * 96, 768, KVMLA + (size_t)bb * LK * 1024 + h * 128, 1024, KPE + (size_t)bb * LK * 32, 32,
                                      KVMLA + (size_t)bb * LK * 1024 + h * 128 + 64, 1024, LK / 64, 0.10206207261596577f * L2E, YALL + ((size_t)2 * CHR + qrow) * 512 + h * 64, 512, 0.f, 1.f, prompt ? nullptr : cos32, sin32, qb * 256);
 }
            for (int pro_ = 0; pro_ < PROBE_O_REPS; ++pro_)
            for (int u = vcu; u < 256; u += G) { const int h = u & 3;
ret_out_unit(lds, RAW, u >> 2, h, LGF(h), LGB(h), SIN, YALL);
 }
            }
        }
        else if (kind == 7) { ENV LAYER_ENV CHUNK_ENV
            const float lam = lamv[l], lam_init = lamv[2 + l];
            for (int prb_ = 0; prb_ < PROBE_EW_REPS; ++prb_)
            for (int r = gw; r < CHR; r += NGW) {
                const float* o1 = ODIFF + (size_t)r * 512 + 8 * lane; const float* o2 = o1 + (size_t)CHR * 512;
                const f32x4 a0 = *(const f32x4*)o1, a1 = *(const f32x4*)(o1 + 4), b0v = *(const f32x4*)o2, b1v = *(const f32x4*)(o2 + 4);
                const f32x4 d0 = a0 - b0v * lam, d1 = a1 - b1v * lam;
                float ss = (d0[0] * d0[0] + d0[1] * d0[1]) + (d0[2] * d0[2] + d0[3] * d0[3]) + (d1[0] * d1[0] + d1[1] * d1[1]) + (d1[2] * d1[2] + d1[3] * d1[3]);
                ss += __shfl_xor(ss, 1); ss += __shfl_xor(ss, 2); ss += __shfl_xor(ss, 4); ss += __shfl_xor(ss, 8);
                const float sc = rsqrtf(ss * (1.0f / 128.0f) + EPSF) * (1.0f - lam_init);
                u32x4 w; w.x = cvt_pk_bf16(d0[0] * sc, d0[1] * sc); w.y = cvt_pk_bf16(d0[2] * sc, d0[3] * sc); w.z = cvt_pk_bf16(d1[0] * sc, d1[1] * sc); w.w = cvt_pk_bf16(d1[2] * sc, d1[3] * sc);
                *(u32x4*)(YALL + ((size_t)CHR + r) * 512 + 8 * lane) = w;
            } }
        else if (kind == 8) { ENV LAYER_ENV CHUNK_ENV
            for (int prg_ = 0; prg_ < PROBE_G4_REPS; ++prg_)
            { pg8::Gemm g{YALL, (const bf16_t*)(wl + WO_BR), 3 * CHR, 3072, 512}; pg8::GateOrder S{CHR / 256, G, bx}; pg8::EpiGate E{RAW, BRG, CHR / 256};

          pg8::gemm_phase<pg8::EpiGate, pg8::GateOrder, true, true>(lds, g, S, E);
 }
        }
        else if (kind == 9) { ENV LAYER_ENV
        for (int prr_ = 0; prr_ < PROBE_R_REPS; ++prr_)
        { pg8::Gemm g{ABUF, (const bf16_t*)(wl + WO_OUT), NTOK, DM, DM}; pg8::StaticOrder S; S.init(NTOK, DM, G, bx); pg8::EpiResid E{xs0, xs1, xres, modl + 2048, prr_ < PROBE_R_REPS - 1};

          pg8::gemm_phase<pg8::EpiResid, pg8::StaticOrder, true, true>(lds, g, S, E);
 }
        }
        else if (kind == 10) { ENV LAYER_ENV
        for (int prb_ = 0; prb_ < PROBE_EW_REPS; ++prb_)
        for (int m = gw; m < NTOK; m += NGW) {
            const int grp = m < NPR ? 0 : 1 + ((m - NPR) >> 12); const float* xr = xres + (size_t)m * DM; const float* md = modl + grp * 6144; const float* gn = pk->in[11] + l * DM;
            f32x4 v[4]; float ss = 0.f;
#pragma unroll
            for (int j = 0; j < 4; ++j) { v[j] = *(const f32x4*)(xr + 4 * lane + 256 * j); ss += (v[j][0] * v[j][0] + v[j][1] * v[j][1]) + (v[j][2] * v[j][2] + v[j][3] * v[j][3]); }
            const float rstd = rsqrtf(wave_sum(ss) * (1.0f / DM) + EPSF);
#pragma unroll
            for (int j = 0; j < 4; ++j) { const int c = 4 * lane + 256 * j; const f32x4 gg = *(const f32x4*)(gn + c), sh = *(const f32x4*)(md + 3072 + c), scv = *(const f32x4*)(md + 4096 + c);
                const f32x4 y = v[j] * rstd * gg * (scv + 1.0f) + sh; u32x2 pw; pw.x = cvt_pk_bf16(y[0], y[1]); pw.y = cvt_pk_bf16(y[2], y[3]);
                *(u32x2*)(ABUF + (size_t)m * DM + c) = pw; }
        } }
        else if (kind == 11) { ENV LAYER_ENV
            for (int prg_ = 0; prg_ < PROBE_G6_REPS; ++prg_)
        { pg8::Gemm g{ABUF, (const bf16_t*)(wl + WO_FI), NTOK, 5632, DM}; pg8::StaticOrder S; S.init(NTOK, 5632, G, bx); pg8::EpiSwiglu E{HID, 2816};

          pg8::gemm_phase<pg8::EpiSwiglu, pg8::StaticOrder, true, true>(lds, g, S, E);
 }
        }
        else if (kind == 12) { ENV LAYER_ENV
        for (int prr_ = 0; prr_ < PROBE_R_REPS; ++prr_)
        { pg8::Gemm g{HID, (const bf16_t*)(wl + WO_FO), NTOK, DM, 2816}; pg8::StaticOrder S; S.init(NTOK, DM, G, bx); pg8::EpiResid E{xres, xres, xres, modl + 5120, prr_ < PROBE_R_REPS - 1};

          pg8::gemm_phase<pg8::EpiResid, pg8::StaticOrder, true, true>(lds, g, S, E);
 }
        }
        else if (kind == 14) { ENV LAYER_ENV CHUNK_ENV
            SUM_ROWS(gw, NGW, row0);
        }
        else { ENV
    for (int m = gw; m < NTOK; m += NGW) {
        float* xr = xres + (size_t)m * DM; const float* gn = pk->in[26];
        f32x4 v[4]; float ss = 0.f;
#pragma unroll
        for (int j = 0; j < 4; ++j) { v[j] = *(const f32x4*)(xr + 4 * lane + 256 * j); ss += (v[j][0] * v[j][0] + v[j][1] * v[j][1]) + (v[j][2] * v[j][2] + v[j][3] * v[j][3]); }
        const float rstd = rsqrtf(wave_sum(ss) * (1.0f / DM) + EPSF);
        f32x4 gv[4];
#pragma unroll
        for (int j = 0; j < 4; ++j) gv[j] = *(const f32x4*)(gn + 4 * lane + 256 * j);
#pragma unroll
        for (int j = 0; j < 4; ++j) { const int c = 4 * lane + 256 * j; *(f32x4*)(xr + c) = v[j] * rstd * gv[j]; }
    } }
        if (ph == 0) grid.sync();
        else if (ph != 73) { KParams* pkb = (KParams*)__builtin_amdgcn_kernarg_segment_ptr(); asm volatile("" : "+s"(pkb));
            XcdBarrier xb_; xb_.bar = (unsigned*)(pkb->ws + WS_CTL); xb_.x = xb_xcc_id(); xb_.st = (volatile LAS unsigned*)(lds + MISC_OFF) + 8; for (int rs_ = 0; rs_ < PROBE_SYNC_REPS; ++rs_) xcd_barrier(xb_); }
    }
}

extern "C" void kernel_launch(void* const* d_in, const int* in_sizes, int n_in, void* d_out, int out_size, void* d_ws, size_t ws_size, hipStream_t stream) {
    static int grid = 0;
    if (grid == 0) {
        if (n_in != 27 || (size_t)out_size != OUT_TOTAL || ws_size < WS_END) { fprintf(stderr, "kernel_launch: unexpected shapes (n_in %d out %d ws %zu)\n", n_in, out_size, ws_size); grid = -1; return; }
        int dev = 0, cus = 0, per_cu = 0;
        hipGetDevice(&dev); hipDeviceGetAttribute(&cus, hipDeviceAttributeMultiprocessorCount, dev);
        if (hipFuncSetAttribute((const void*)fwd_megakernel, hipFuncAttributeMaxDynamicSharedMemorySize, LDS_BYTES) != hipSuccess) { fprintf(stderr, "kernel_launch: hipFuncSetAttribute failed\n"); grid = -1; return; }
        if (hipOccupancyMaxActiveBlocksPerMultiprocessor(&per_cu, (const void*)fwd_megakernel, NT, LDS_BYTES) != hipSuccess || per_cu < 1) { fprintf(stderr, "kernel_launch: occupancy query says %d\n", per_cu); per_cu = 1; }
        (void)hipGetLastError();
        grid = cus;
    }
    if (grid < 0) return;
    if (hipMemsetAsync((char*)d_ws + WS_CTL, 0, 65536, stream) != hipSuccess) { fprintf(stderr, "kernel_launch: memset failed\n"); return; }
    Params p{};
    for (int i = 0; i < 27; ++i) p.in[i] = (const float*)d_in[i];
    p.out = (float*)d_out; p.ws = (unsigned char*)d_ws;
    void* args[] = {&p};
    hipError_t e = hipLaunchCooperativeKernel((const void*)fwd_megakernel, dim3(grid), dim3(NT), args, LDS_BYTES, stream);
    if (e != hipSuccess) fprintf(stderr, "cooperative launch failed: %s (grid %d)\n", hipGetErrorString(e), grid);
}
```

```cpp
#include <hip/hip_runtime.h>
#include <hip/hip_cooperative_groups.h>
#include <cstdio>
#include <cstdint>
namespace cg = cooperative_groups;
#ifndef PROBE_E_REPS
#define PROBE_E_REPS 1
#endif
#ifndef PROBE_SYNC_REPS
#define PROBE_SYNC_REPS 1
#endif
#ifndef PROBE_EW_REPS
#define PROBE_EW_REPS 1
#endif
#ifndef PROBE_G1_REPS
#define PROBE_G1_REPS 1
#endif
#ifndef PROBE_G4_REPS
#define PROBE_G4_REPS 1
#endif
#ifndef PROBE_G6_REPS
#define PROBE_G6_REPS 1
#endif
#ifndef PROBE_C_REPS
#define PROBE_C_REPS 1
#endif
#ifndef PROBE_R_REPS
#define PROBE_R_REPS 1
#endif
#ifndef PROBE_D_REPS
#define PROBE_D_REPS 1
#endif
#ifndef PROBE_O_REPS
#define PROBE_O_REPS 1
#endif
#ifndef PROBE_MFMA
#define PROBE_MFMA 0
#endif
#ifndef PROBE_FA_MODE
#define PROBE_FA_MODE 0
#endif
namespace pg8 {
#define PG8_LAS __attribute__((address_space(3)))
typedef unsigned short bf16_t;
typedef short bf16x8 __attribute__((ext_vector_type(8)));
typedef float f32x4 __attribute__((ext_vector_type(4)));
typedef unsigned u32x4 __attribute__((ext_vector_type(4)));
constexpr int BM = 256, BK = 64, HALF = 128, HTB = HALF * BK * 2  , STAGE_BYTES = 8 * HTB, NXCD = 8, WGM = 8;

__host__ __device__ __forceinline__ int lds_byte(int r, int c) { const int st = (r >> 4) * 2 + (c >> 5), rr = r & 15, cc = c & 31, ob = rr * 64 + cc * 2; return st * 1024 + (ob ^ (((ob >> 9) & 1) << 5)); }
__host__ __device__ __forceinline__ void stage_rc(int b, int& R, int& C) { const int st = b / 1024, sb = b % 1024, swz = sb ^ (((sb >> 9) & 1) << 5); R = (st >> 1) * 16 + swz / 64; C = (st & 1) * 32 + (swz % 64) / 2; }
__host__ __device__ __forceinline__ int perm32(int rho) { const int n = rho >> 4, i = rho & 15; return 8 * (i >> 2) + 4 * n + (i & 3); }

struct Unit { int pm, pn; };
struct Gemm { const bf16_t* A; const bf16_t* Bt; int M, N, K; };

struct StaticOrder {
    int nM, nN, nwg, G, c;
    __host__ __device__ void init(int M, int N, int G_, int c_) { nM = M / BM; nN = N / BM; nwg = nM * nN; G = G_; c = c_; }
    __host__ __device__ bool next(int i, Unit& u) const {
        const long L = (long)i * G + c; if (L >= nwg) return false;
        int wgid = (int)L; { const int q = nwg / NXCD, r = nwg % NXCD, xcd = wgid % NXCD, off = wgid / NXCD; wgid = (xcd < r ? xcd * (q + 1) : r * (q + 1) + (xcd - r) * q) + off; }
        const int nig = WGM * nN, gid = wgid / nig, fm = gid * WGM, gsz = (nM - fm) < WGM ? (nM - fm) : WGM;
        u.pm = fm + ((wgid % nig) % gsz); u.pn = (wgid % nig) / gsz; return true;
    }
    __device__ __forceinline__ void a_ready(const Unit&) const {}
    __device__ __forceinline__ void done(const Unit&) const {}
};

typedef float f32x2c_t __attribute__((ext_vector_type(2))); typedef __bf16 bf16x2c_t __attribute__((ext_vector_type(2)));
__device__ __forceinline__ unsigned cvt_pk_bf16(float lo, float hi) { const f32x2c_t v = {lo, hi}; const bf16x2c_t b = __builtin_convertvector(v, bf16x2c_t); return __builtin_bit_cast(unsigned, b); }
typedef float f32x2 __attribute__((ext_vector_type(2)));
typedef unsigned u32x2 __attribute__((ext_vector_type(2)));
__device__ __forceinline__ float bf_lo(unsigned w) { return __uint_as_float(w << 16); }
__device__ __forceinline__ float bf_hi(unsigned w) { return __uint_as_float(w & 0xffff0000u); }
__device__ __forceinline__ float sigmoidf_(float x) { return __builtin_amdgcn_rcpf(1.0f + __expf(-x)); }
__device__ __forceinline__ float siluf_(float x) { return x * __builtin_amdgcn_rcpf(1.0f + __expf(-x)); }

struct EpiRaw {
    static constexpr bool PERM = true, AFTER_DRAIN = false;
    bf16_t* O; int ldc;
    __device__ __forceinline__ void operator()(const f32x4 (&acc)[2][2][4][2], const Unit& u, int wr, int wc, int fr, int fq) const {
        const int row0 = u.pm * BM + wr * 64 + fr, col0 = u.pn * BM + wc * 32 + 8 * fq;
#pragma unroll
        for (int ai = 0; ai < 2; ++ai)
#pragma unroll
            for (int m = 0; m < 4; ++m) { bf16_t* rowp = O + (size_t)(row0 + ai * HALF + m * 16) * ldc + col0;
#pragma unroll
                for (int bj = 0; bj < 2; ++bj) { const f32x4 v0 = acc[ai][bj][m][0], v1 = acc[ai][bj][m][1];
                    u32x4 w; w.x = cvt_pk_bf16(v0[0], v0[1]); w.y = cvt_pk_bf16(v0[2], v0[3]); w.z = cvt_pk_bf16(v1[0], v1[1]); w.w = cvt_pk_bf16(v1[2], v1[3]);
                    *(u32x4*)(rowp + bj * HALF) = w; } }
    }
};
struct EpiSwiglu {
    static constexpr bool PERM = true, AFTER_DRAIN = false;
    bf16_t* O; int ldc;
    __device__ __forceinline__ void operator()(const f32x4 (&acc)[2][2][4][2], const Unit& u, int wr, int wc, int fr, int fq) const {
        const int row0 = u.pm * BM + wr * 64 + fr, col0 = u.pn * HALF + wc * 32 + 8 * fq;
#pragma unroll
        for (int ai = 0; ai < 2; ++ai)
#pragma unroll
            for (int m = 0; m < 4; ++m) { bf16_t* rowp = O + (size_t)(row0 + ai * HALF + m * 16) * ldc + col0;
                float r[8];
#pragma unroll
                for (int n = 0; n < 2; ++n)
#pragma unroll
                    for (int e = 0; e < 4; ++e) r[n * 4 + e] = siluf_(acc[ai][0][m][n][e]) * acc[ai][1][m][n][e];
                u32x4 w; w.x = cvt_pk_bf16(r[0], r[1]); w.y = cvt_pk_bf16(r[2], r[3]); w.z = cvt_pk_bf16(r[4], r[5]); w.w = cvt_pk_bf16(r[6], r[7]);
                *(u32x4*)rowp = w; }
    }
};
struct EpiResid {
    static constexpr bool PERM = false, AFTER_DRAIN = false;
    const float* src0; const float* src1; float* out; const float* gate;
    int dry;
    __device__ __forceinline__ void operator()(const f32x4 (&acc)[2][2][4][2], const Unit& u, int wr, int wc, int fr, int fq) const {
        const int R0 = u.pm * BM; const int grp = R0 < 8192 ? 0 : 1 + ((R0 - 8192) >> 12);
        const float* src = R0 < 8192 ? src0 : src1; const float* gv = gate + grp * 6144;
        const int col0 = u.pn * BM + wc * 32 + 4 * fq;
        f32x4 gt[2][2];
#pragma unroll
        for (int bj = 0; bj < 2; ++bj)
#pragma unroll
            for (int n = 0; n < 2; ++n) gt[bj][n] = *(const f32x4*)(gv + col0 + bj * HALF + n * 16);
#pragma unroll
        for (int ai = 0; ai < 2; ++ai)
#pragma unroll
            for (int mp = 0; mp < 2; ++mp) { f32x4 b[2][2][2];
#pragma unroll
                for (int mm = 0; mm < 2; ++mm) { const size_t off = (size_t)(R0 + ai * HALF + wr * 64 + (2 * mp + mm) * 16 + fr) * 1024 + col0;
#pragma unroll
                    for (int bj = 0; bj < 2; ++bj)
#pragma unroll
                        for (int n = 0; n < 2; ++n) b[mm][bj][n] = *(const f32x4*)(src + off + bj * HALF + n * 16); }
#pragma unroll
                for (int mm = 0; mm < 2; ++mm) { const int m = 2 * mp + mm; const size_t off = (size_t)(R0 + ai * HALF + wr * 64 + m * 16 + fr) * 1024 + col0;
#pragma unroll
                    for (int bj = 0; bj < 2; ++bj)
#pragma unroll
                        for (int n = 0; n < 2; ++n) { if (!dry) *(f32x4*)(out + off + bj * HALF + n * 16) = b[mm][bj][n] + gt[bj][n] * acc[ai][bj][m][n]; } }
                asm volatile("" ::: "memory"); }
    }
};
struct EpiGate {
    static constexpr bool PERM = true, AFTER_DRAIN = false;
    const bf16_t* raw; bf16_t* brg; int MT;
    __device__ __forceinline__ void operator()(const f32x4 (&acc)[2][2][4][2], const Unit& u, int wr, int wc, int fr, int fq) const {
        const int g = u.pn >> 2, pn = u.pn & 3, pm = u.pm - g * MT;
        const int row0 = pm * BM + wr * 64 + fr, col0 = pn * BM + wc * 32 + 8 * fq;
        bf16_t* out = brg + (size_t)g * MT * BM * 1024;
#pragma unroll
        for (int ai = 0; ai < 2; ++ai) { u32x4 gwv[4][2];
#pragma unroll
            for (int m = 0; m < 4; ++m)
#pragma unroll
                for (int bj = 0; bj < 2; ++bj) gwv[m][bj] = *(const u32x4*)(raw + (size_t)(row0 + ai * HALF + m * 16) * 6912 + 3744 + g * 1024 + col0 + bj * HALF);
#pragma unroll
            for (int m = 0; m < 4; ++m) { const int row = row0 + ai * HALF + m * 16;
#pragma unroll
                for (int bj = 0; bj < 2; ++bj) { const int col = col0 + bj * HALF; const u32x4 gw = gwv[m][bj];
                    f32x4 v0 = acc[ai][bj][m][0], v1 = acc[ai][bj][m][1];
                    v0[0] *= sigmoidf_(bf_lo(gw.x)); v0[1] *= sigmoidf_(bf_hi(gw.x)); v0[2] *= sigmoidf_(bf_lo(gw.y)); v0[3] *= sigmoidf_(bf_hi(gw.y));
                    v1[0] *= sigmoidf_(bf_lo(gw.z)); v1[1] *= sigmoidf_(bf_hi(gw.z)); v1[2] *= sigmoidf_(bf_lo(gw.w)); v1[3] *= sigmoidf_(bf_hi(gw.w));
                    u32x4 w; w.x = cvt_pk_bf16(v0[0], v0[1]); w.y = cvt_pk_bf16(v0[2], v0[3]); w.z = cvt_pk_bf16(v1[0], v1[1]); w.w = cvt_pk_bf16(v1[2], v1[3]);
                    *(u32x4*)(out + (size_t)row * 1024 + col) = w; } }
            asm volatile("" ::: "memory"); }
    }
};
struct GateOrder {
    int MT, G, c;
    __device__ bool next(int i, Unit& u) const { const int L = i * G + c; if (L >= 3 * MT * 4) return false; const int g = L / (4 * MT), t = L % (4 * MT); u.pm = g * MT + (t >> 2); u.pn = g * 4 + (t & 3); return true; }
    __device__ __forceinline__ void a_ready(const Unit&) const {}
    __device__ __forceinline__ void done(const Unit&) const {}
};
struct OffsetOrder {
    StaticOrder S;
    __device__ void init(int M, int N, int G, int c, int off) { S.init(M, N, G, (c - off + G) % G); }
    __device__ bool next(int i, Unit& u) const { return S.next(i, u); }
    __device__ __forceinline__ void a_ready(const Unit&) const {}
    __device__ __forceinline__ void done(const Unit&) const {}
};
template <class Epi, class Sched, bool ALIGN_EPI = false, bool SP2 = false>
__device__ __forceinline__ void gemm_phase(PG8_LAS unsigned char* lds, const Gemm g, const Sched& S, const Epi& E) {
    int tid = threadIdx.x; asm volatile("" : "+v"(tid)); const int wid = __builtin_amdgcn_readfirstlane(tid >> 6), lane = tid & 63, wr = wid >> 2, wc = wid & 3, fr = lane & 15, fq = lane >> 4;
    const int K = g.K, nt = K / BK;
    unsigned voffA[2], voffB[2];
#pragma unroll
    for (int i = 0; i < 2; ++i) { int R, C; stage_rc(tid * 16 + i * 8192, R, C); const int Rb = Epi::PERM ? ((R & ~31) + perm32(R & 31)) : R;
        voffA[i] = (unsigned)(R * K + C) * 2u; voffB[i] = (unsigned)(Rb * K + C) * 2u; }
    const size_t kstep = (size_t)(BK * 2);
    const size_t hstep = (size_t)HALF * K * 2;
    const size_t tstep = 2 * hstep;
    const unsigned ldsw = (unsigned)wid * 1024u;
    const int aoff = lds_byte(wr * 64 + fr, fq * 8), boff = lds_byte(wc * 32 + fr, fq * 8);
#define PG8_SA(b, h) (((b) * 2 + (h)) * HTB)
#define PG8_SB(b, h) ((4 + (b) * 2 + (h)) * HTB)
#define PG8_STAGE(bufoff, gbase, voff) do { _Pragma("unroll") for (int _i = 0; _i < 2; ++_i) \
        __builtin_amdgcn_global_load_lds((const unsigned*)((const char*)(gbase) + (voff)[_i]), (PG8_LAS unsigned*)(lds + (bufoff) + ldsw + _i * 8192), 16, 0, 0); } while (0)
#define PG8_LDA(dst, b, h) do { _Pragma("unroll") for (int m = 0; m < 4; ++m) _Pragma("unroll") for (int k = 0; k < 2; ++k) dst[m][k] = *(const PG8_LAS bf16x8*)(lds + PG8_SA(b, h) + aoff + m * 2048 + k * 1024); } while (0)
#define PG8_LDB(dst, b, h) do { _Pragma("unroll") for (int n = 0; n < 2; ++n) _Pragma("unroll") for (int k = 0; k < 2; ++k) dst[n][k] = *(const PG8_LAS bf16x8*)(lds + PG8_SB(b, h) + boff + n * 2048 + k * 1024); } while (0)
#define PG8_MMA(ai, bj, At, Bt) do { __builtin_amdgcn_s_setprio(1); _Pragma("unroll") for (int m = 0; m < 4; ++m) _Pragma("unroll") for (int n = 0; n < 2; ++n) _Pragma("unroll") for (int k = 0; k < 2; ++k) \
        acc[ai][bj][m][n] = __builtin_amdgcn_mfma_f32_16x16x32_bf16(Bt[n][k], At[m][k], acc[ai][bj][m][n], 0, 0, 0); __builtin_amdgcn_s_setprio(0); } while (0)
#define PG8_WAIT_V(n) asm volatile("s_waitcnt vmcnt(" #n ")" ::: "memory")
#define PG8_WAIT_L(n) asm volatile("s_waitcnt lgkmcnt(" #n ")" ::: "memory")
#define PG8_BAR __builtin_amdgcn_s_barrier()
#define PG8_SCHED __builtin_amdgcn_sched_barrier(0)
    Unit cur, nxt; int ui = 0;
    if (!S.next(0, cur)) return;
    f32x4 acc[2][2][4][2];
#pragma unroll
    for (int a = 0; a < 2; ++a)
#pragma unroll
        for (int b = 0; b < 2; ++b)
#pragma unroll
            for (int m = 0; m < 4; ++m)
#pragma unroll
                for (int n = 0; n < 2; ++n) acc[a][b][m][n] = (f32x4){0.f, 0.f, 0.f, 0.f};
    bf16x8 At[4][2], B0[2][2], B1[2][2];
    const char* cA = (const char*)g.A + (size_t)cur.pm * tstep; const char* cB = (const char*)g.Bt + (size_t)cur.pn * tstep;
    S.a_ready(cur);
    if constexpr (SP2) {
        PG8_STAGE(PG8_SB(0, 0), cB, voffB); PG8_STAGE(PG8_SB(0, 1), cB + hstep, voffB); PG8_STAGE(PG8_SA(0, 0), cA, voffA); PG8_STAGE(PG8_SA(0, 1), cA + hstep, voffA);
        if (wr == 1) PG8_BAR;
        PG8_WAIT_V(2); PG8_BAR;
        PG8_STAGE(PG8_SB(1, 0), cB + kstep, voffB); PG8_STAGE(PG8_SA(1, 0), cA + kstep, voffA); PG8_STAGE(PG8_SB(1, 1), cB + hstep + kstep, voffB);
        PG8_WAIT_V(6); PG8_BAR;
    } else {
        PG8_STAGE(PG8_SB(0, 0), cB, voffB); PG8_STAGE(PG8_SA(0, 0), cA, voffA); PG8_STAGE(PG8_SB(0, 1), cB + hstep, voffB); PG8_STAGE(PG8_SA(0, 1), cA + hstep, voffA);
        if (wr == 1) PG8_BAR;
        PG8_WAIT_V(4); PG8_BAR;
        PG8_STAGE(PG8_SB(1, 0), cB + kstep, voffB); PG8_STAGE(PG8_SA(1, 0), cA + kstep, voffA); PG8_STAGE(PG8_SB(1, 1), cB + hstep + kstep, voffB);
        PG8_WAIT_V(6); PG8_BAR;
    }
    for (;;) {
        const bool has_next = S.next(ui + 1, nxt);
        const char* nA = has_next ? (const char*)g.A + (size_t)nxt.pm * tstep : cA; const char* nB = has_next ? (const char*)g.Bt + (size_t)nxt.pn * tstep : cB;
        for (int t = 0; t < nt; t += 2) {
            const bool last = (t == nt - 2);
            const char* a1 = cA + (size_t)(t + 1) * kstep;
            const char* a2 = last ? nA : cA + (size_t)(t + 2) * kstep; const char* b2 = last ? nB : cB + (size_t)(t + 2) * kstep;
            const char* a3 = a2 + kstep; const char* b3 = b2 + kstep;
            if (last && has_next) S.a_ready(nxt);
            if constexpr (SP2) {
            PG8_LDB(B0, 0, 0); PG8_LDB(B1, 0, 1); PG8_SCHED; PG8_LDA(At, 0, 0); PG8_STAGE(PG8_SA(1, 1), a1 + hstep, voffA);
            PG8_WAIT_V(8); PG8_WAIT_L(0); PG8_BAR; PG8_MMA(0, 0, At, B0); PG8_MMA(0, 1, At, B1); PG8_BAR; PG8_SCHED;
            PG8_LDA(At, 0, 1); PG8_STAGE(PG8_SB(0, 0), b2, voffB); PG8_STAGE(PG8_SB(0, 1), b2 + hstep, voffB); PG8_STAGE(PG8_SA(0, 0), a2, voffA);
            PG8_WAIT_V(8); PG8_WAIT_L(0); PG8_BAR; PG8_MMA(1, 0, At, B0); PG8_MMA(1, 1, At, B1); PG8_BAR; PG8_SCHED;
            PG8_LDB(B0, 1, 0); PG8_LDB(B1, 1, 1); PG8_SCHED; PG8_LDA(At, 1, 0); PG8_STAGE(PG8_SA(0, 1), a2 + hstep, voffA);
            PG8_WAIT_V(8); PG8_WAIT_L(0); PG8_BAR; PG8_MMA(0, 0, At, B0); PG8_MMA(0, 1, At, B1); PG8_BAR; PG8_SCHED;
            PG8_LDA(At, 1, 1); PG8_STAGE(PG8_SB(1, 0), b3, voffB); PG8_STAGE(PG8_SB(1, 1), b3 + hstep, voffB); PG8_STAGE(PG8_SA(1, 0), a3, voffA);
            PG8_WAIT_V(8); PG8_WAIT_L(0); PG8_BAR; PG8_MMA(1, 0, At, B0); PG8_MMA(1, 1, At, B1); PG8_BAR; PG8_SCHED;
            } else {
            PG8_LDB(B0, 0, 0); PG8_SCHED; PG8_LDA(At, 0, 0); PG8_STAGE(PG8_SA(1, 1), a1 + hstep, voffA);
            PG8_WAIT_L(8); PG8_BAR; PG8_WAIT_L(0); PG8_MMA(0, 0, At, B0); PG8_BAR; PG8_SCHED;
            PG8_LDB(B1, 0, 1); PG8_STAGE(PG8_SB(0, 0), b2, voffB);
            PG8_BAR; PG8_WAIT_L(0); PG8_MMA(0, 1, At, B1); PG8_BAR;
            PG8_LDA(At, 0, 1); PG8_STAGE(PG8_SA(0, 0), a2, voffA);
            PG8_BAR; PG8_WAIT_L(0); PG8_MMA(1, 0, At, B0); PG8_BAR; PG8_SCHED;
            PG8_STAGE(PG8_SB(0, 1), b2 + hstep, voffB);
            PG8_WAIT_V(6); PG8_BAR; PG8_MMA(1, 1, At, B1); PG8_BAR;
            PG8_LDB(B0, 1, 0); PG8_SCHED; PG8_LDA(At, 1, 0); PG8_STAGE(PG8_SA(0, 1), a2 + hstep, voffA);
            PG8_WAIT_L(8); PG8_BAR; PG8_WAIT_L(0); PG8_MMA(0, 0, At, B0); PG8_BAR; PG8_SCHED;
            PG8_LDB(B1, 1, 1); PG8_STAGE(PG8_SB(1, 0), b3, voffB);
            PG8_BAR; PG8_WAIT_L(0); PG8_MMA(0, 1, At, B1); PG8_BAR;
            PG8_LDA(At, 1, 1); PG8_STAGE(PG8_SA(1, 0), a3, voffA);
            PG8_BAR; PG8_WAIT_L(0); PG8_MMA(1, 0, At, B0); PG8_BAR; PG8_SCHED;
            PG8_STAGE(PG8_SB(1, 1), b3 + hstep, voffB);
            PG8_WAIT_V(6); PG8_BAR; PG8_MMA(1, 1, At, B1); PG8_BAR;
            }
        }
        if constexpr (ALIGN_EPI) { if (wr == 0) PG8_BAR; }
        if constexpr (!Epi::AFTER_DRAIN) { E(acc, cur, wr, wc, fr, fq); S.done(cur); }
        if (!has_next) break;
#pragma unroll
        for (int a = 0; a < 2; ++a)
#pragma unroll
            for (int b = 0; b < 2; ++b)
#pragma unroll
                for (int m = 0; m < 4; ++m)
#pragma unroll
                    for (int n = 0; n < 2; ++n) acc[a][b][m][n] = (f32x4){0.f, 0.f, 0.f, 0.f};
        cur = nxt; cA = nA; cB = nB; ++ui;
        if constexpr (ALIGN_EPI) { if (wr == 1) PG8_BAR; }
    }
    PG8_WAIT_V(0);
    if constexpr (!ALIGN_EPI) { if (wr == 0) PG8_BAR; }
    PG8_BAR;
    if constexpr (Epi::AFTER_DRAIN) { E.fused(acc, cur, wr, wc, fr, fq, lds, wid, lane); S.done(cur); }
#undef PG8_SA
#undef PG8_SB
#undef PG8_STAGE
#undef PG8_LDA
#undef PG8_LDB
#undef PG8_MMA
#undef PG8_WAIT_V
#undef PG8_WAIT_L
#undef PG8_BAR
#undef PG8_SCHED
}
}
#define LAS __attribute__((address_space(3)))
typedef unsigned short bf16_t;
typedef short bf16x8 __attribute__((ext_vector_type(8)));
typedef short s16x4 __attribute__((ext_vector_type(4)));
typedef float f32x4 __attribute__((ext_vector_type(4)));
typedef unsigned u32x4 __attribute__((ext_vector_type(4)));
using pg8::u32x2; using pg8::cvt_pk_bf16; using pg8::bf_lo; using pg8::bf_hi; using pg8::siluf_;
constexpr int NT = 512;
constexpr int DM = 1024, NTOK = 40960, NPR = 8192, NINP = 6912, CHR = 8192, NCOLA = 6144;
constexpr float EPSF = 1e-6f, L2E = 1.4426950408889634f;
constexpr size_t MiB = 1u << 20;
constexpr size_t WS_MOD = 0, WS_LAM = 512 * 1024, WS_ROPE = 1 * MiB, WS_W = 4 * MiB, WL_STRIDE = 37 * MiB;
constexpr size_t WO_IN = 0, WO_UQ = 13 * MiB + 512 * 1024, WO_UKV = 14 * MiB + 256 * 1024, WO_BR = 15 * MiB, WO_OUT = 18 * MiB, WO_FI = 20 * MiB, WO_FO = 31 * MiB;
constexpr size_t WS_ABUF = 78 * MiB, WS_RAW = 158 * MiB, WS_CQN = 266 * MiB, WS_CKVN = 272 * MiB, WS_KPE = 277 * MiB, WS_QMLA = 278 * MiB, WS_KVMLA = 290 * MiB,
                 WS_DKV = 308 * MiB, WS_ODIFF = 326 * MiB, WS_YALL = 358 * MiB, WS_U = 382 * MiB, WS_SIN = 398 * MiB, WS_HID = 158 * MiB, WS_BRG = 382 * MiB  , WS_END = 430 * MiB;
constexpr size_t OUT_YP = 0, OUT_RF = 41943040, OUT_RB = 44040192, OUT_DK = 46137344, OUT_DV = 54525952, OUT_CKV = 62914560, OUT_KPE = 67108864, OUT_TOTAL = 67633152;
constexpr int LDS_BYTES = 147456, MISC_OFF = 131072 + 320;
constexpr size_t WS_CTL = 3 * MiB;

__device__ __forceinline__ float bf2f(bf16_t v) { return __uint_as_float((unsigned)v << 16); }
__device__ __forceinline__ bf16_t f2bf(float f) { unsigned u = __float_as_uint(f); return (bf16_t)((u + 0x7fffu + ((u >> 16) & 1u)) >> 16); }
__device__ __forceinline__ float wave_sum(float v) {
#pragma unroll
    for (int o = 1; o < 64; o <<= 1) v += __shfl_xor(v, o);
    return v;
}
__device__ __forceinline__ s16x4 ds_tr(const LAS unsigned char* p) { return __builtin_bit_cast(s16x4, __builtin_amdgcn_ds_read_tr16_b64_v4i16((LAS s16x4*)p)); }
__device__ __forceinline__ bf16x8 tr2(const LAS unsigned char* p, int rowskip_bytes) { const s16x4 a = ds_tr(p), b = ds_tr(p + rowskip_bytes); return (bf16x8){a[0], a[1], a[2], a[3], b[0], b[1], b[2], b[3]}; }
__device__ __forceinline__ bf16x8 pack8(const f32x4 a, const f32x4 b) { u32x4 w; w.x = cvt_pk_bf16(a[0], a[1]); w.y = cvt_pk_bf16(a[2], a[3]); w.z = cvt_pk_bf16(b[0], b[1]); w.w = cvt_pk_bf16(b[2], b[3]); return __builtin_bit_cast(bf16x8, w); }
#define MFMA16(a, b, c) __builtin_amdgcn_mfma_f32_16x16x32_bf16((a), (b), (c), 0, 0, 0)

struct Params { const float* in[27]; float* out; unsigned char* ws; };

__device__ __forceinline__ void transpose_item(const float* W, int K, int N, bf16_t* WT, int k0, int n0, int dst_row0, LAS float* scr, int lane) {
#pragma unroll
    for (int i = 0; i < 32; ++i) { const int kk = 2 * i + (lane >> 5); scr[kk * 33 + (lane & 31)] = W[(size_t)(k0 + kk) * N + n0 + (lane & 31)]; }
    asm volatile("s_waitcnt lgkmcnt(0)" ::: "memory");
    const int c = lane & 7;
#pragma unroll
    for (int j = 0; j < 4; ++j) { const int n = (lane >> 3) + 8 * j; const LAS float* s = scr + (8 * c) * 33 + n;
        u32x4 o; o.x = cvt_pk_bf16(s[0 * 33], s[1 * 33]); o.y = cvt_pk_bf16(s[2 * 33], s[3 * 33]); o.z = cvt_pk_bf16(s[4 * 33], s[5 * 33]); o.w = cvt_pk_bf16(s[6 * 33], s[7 * 33]);
        *(u32x4*)(WT + (size_t)(dst_row0 + n) * K + k0 + 8 * c) = o; }
    asm volatile("s_waitcnt lgkmcnt(0)" ::: "memory");
}

__device__ __forceinline__ float xmax16(float v) { auto r = __builtin_amdgcn_permlane16_swap(__float_as_uint(v), __float_as_uint(v), false, false); return fmaxf(__uint_as_float(r[0]), __uint_as_float(r[1])); }
__device__ __forceinline__ float xmax32(float v) { auto r = __builtin_amdgcn_permlane32_swap(__float_as_uint(v), __float_as_uint(v), false, false); return fmaxf(__uint_as_float(r[0]), __uint_as_float(r[1])); }
__device__ __forceinline__ float xsum16(float v) { auto r = __builtin_amdgcn_permlane16_swap(__float_as_uint(v), __float_as_uint(v), false, false); return __uint_as_float(r[0]) + __uint_as_float(r[1]); }
__device__ __forceinline__ float xsum32(float v) { auto r = __builtin_amdgcn_permlane32_swap(__float_as_uint(v), __float_as_uint(v), false, false); return __uint_as_float(r[0]) + __uint_as_float(r[1]); }
__device__ __forceinline__ bf16x8 scale8(bf16x8 v, float sc) { const u32x4 w = __builtin_bit_cast(u32x4, v); u32x4 o;
    o.x = cvt_pk_bf16(bf_lo(w.x) * sc, bf_hi(w.x) * sc); o.y = cvt_pk_bf16(bf_lo(w.y) * sc, bf_hi(w.y) * sc); o.z = cvt_pk_bf16(bf_lo(w.z) * sc, bf_hi(w.z) * sc); o.w = cvt_pk_bf16(bf_lo(w.w) * sc, bf_hi(w.w) * sc);
    return __builtin_bit_cast(bf16x8, o); }
#define FA_BAR() do { asm volatile("s_waitcnt lgkmcnt(0)" ::: "memory"); __builtin_amdgcn_s_barrier(); asm volatile("" ::: "memory"); } while (0)
template <int DQK, int DV, bool OUT_BF16, bool TWO = false>
__device__ __forceinline__ void fa_unit(LAS unsigned char* lds, const bf16_t* __restrict__ Q, int qpitch, const bf16_t* __restrict__ K1, int k1pitch,
                                        const bf16_t* __restrict__ K2, int k2pitch, const bf16_t* __restrict__ V, int vpitch, int nkt, float sc, void* Out, int opitch, float lam = 0.f, float osc = 1.f, const float* rcos = nullptr, const float* rsin = nullptr, int pos0 = 0) {
    constexpr int KW = TWO ? 2 * DQK : DQK;
    constexpr int PK = KW + 8, VROW = DV * 2, KB = 64 * PK * 2, VB = 64 * VROW, STG = KB + VB;
    constexpr int KCH = KW / 8, VCH = DV / 8, NK = 64 * KCH, NV = 64 * VCH, KI = (NK + NT - 1) / NT, VI = (NV + NT - 1) / NT, NKS = DQK / 32, NET = DV / 16;
    static_assert(NV % NT == 0 && (NK % NT == 0 || NK - NT * (KI - 1) <= NT) && (NET == 4 || NET == 8), "staging piece counts");
    constexpr int EPP = 32 / (2 * NET);
    int tid = threadIdx.x; asm volatile("" : "+v"(tid)); const int lane = tid & 63, w = tid >> 6, g = lane >> 4, i16 = lane & 15;
    bf16x8 qf[2][NKS];
#pragma unroll
    for (int qt = 0; qt < 2; ++qt)
#pragma unroll
        for (int ks = 0; ks < NKS; ++ks) qf[qt][ks] = scale8(*(const bf16x8*)(Q + (size_t)(TWO ? 16 * w + i16 : 32 * w + 16 * qt + i16) * qpitch + (TWO ? DQK * qt : 0) + 32 * ks + 8 * g), sc);
    if (DQK == 96 && rcos != nullptr) {
#pragma unroll
        for (int qt = 0; qt < 2; ++qt) { const int pos = pos0 + 32 * w + 16 * qt + i16; const float* cp = rcos + (size_t)pos * 16 + 8 * (g & 1); const float* sp = rsin + (size_t)pos * 16 + 8 * (g & 1);
            const f32x4 c0 = *(const f32x4*)cp, c1 = *(const f32x4*)(cp + 4), s0 = *(const f32x4*)sp, s1 = *(const f32x4*)(sp + 4);
            const u32x4 me = __builtin_bit_cast(u32x4, qf[qt][NKS - 1]); u32x4 ot;
#pragma unroll
            for (int q = 0; q < 4; ++q) { const unsigned mw = q == 0 ? me.x : q == 1 ? me.y : q == 2 ? me.z : me.w;
                auto rr = __builtin_amdgcn_permlane32_swap(mw, mw, false, false); const unsigned pw = lane < 32 ? rr[1] : rr[0];
                const float cA = q < 2 ? c0[2 * q] : c1[2 * q - 4], cB = q < 2 ? c0[2 * q + 1] : c1[2 * q - 3], sA = q < 2 ? s0[2 * q] : s1[2 * q - 4], sB = q < 2 ? s0[2 * q + 1] : s1[2 * q - 3];
                const float sg = lane < 32 ? -1.0f : 1.0f;
                const float yA = bf_lo(mw) * cA + sg * bf_lo(pw) * sA, yB = bf_hi(mw) * cB + sg * bf_hi(pw) * sB;
                const unsigned ow = cvt_pk_bf16(yA, yB); if (q == 0) ot.x = ow; else if (q == 1) ot.y = ow; else if (q == 2) ot.z = ow; else ot.w = ow; }
            qf[qt][NKS - 1] = __builtin_bit_cast(bf16x8, ot); }
    }
    f32x4 o[NET][2];
#pragma unroll
    for (int et = 0; et < NET; ++et) { o[et][0] = (f32x4){0.f, 0.f, 0.f, 0.f}; o[et][1] = (f32x4){0.f, 0.f, 0.f, 0.f}; }
    f32x4 lacc[2] = {(f32x4){0.f, 0.f, 0.f, 0.f}, (f32x4){0.f, 0.f, 0.f, 0.f}};
    const bf16x8 ones = (bf16x8){0x3F80, 0x3F80, 0x3F80, 0x3F80, 0x3F80, 0x3F80, 0x3F80, 0x3F80};
    f32x4 negm[2] = {(f32x4){0.f, 0.f, 0.f, 0.f}, (f32x4){0.f, 0.f, 0.f, 0.f}};
    u32x4 kr0[KI], vr0[VI];
#define FA_IDXK(ii) ((tid + NT * (ii)) < NK ? (tid + NT * (ii)) : (tid + NT * (ii)) - NT)
#define FA_GLOADK(kt_, kreg) do { const int ktc_ = (kt_) < nkt ? (kt_) : nkt - 1; \
        _Pragma("unroll") for (int ii = 0; ii < KI; ++ii) { const int idx = FA_IDXK(ii); const int row = idx / KCH, ch = idx % KCH; \
            const bf16_t* src = (TWO || ch < 8) ? K1 + (size_t)(64 * ktc_ + row) * k1pitch + ch * 8 : K2 + (size_t)(64 * ktc_ + row) * k2pitch + (ch - 8) * 8; kreg[ii] = *(const u32x4*)src; } } while (0)
#define FA_GLOADV(vt_, vreg) do { const int vtc_ = (vt_) < nkt ? (vt_) : nkt - 1; \
        _Pragma("unroll") for (int ii = 0; ii < VI; ++ii) { const int idx = tid + NT * ii; const int row = idx / VCH, ch = idx % VCH; \
            vreg[ii] = *(const u32x4*)(V + (size_t)(64 * vtc_ + row) * vpitch + ch * 8); } } while (0)
#define FA_LWRITEK(stg, kreg) do { \
        _Pragma("unroll") for (int ii = 0; ii < KI; ++ii) { const int idx = FA_IDXK(ii); const int row = idx / KCH, ch = idx % KCH; *(LAS u32x4*)(lds + (stg) * STG + row * (PK * 2) + ch * 16) = kreg[ii]; } } while (0)
#define FA_LWRITEV(stg, vreg) do { \
        _Pragma("unroll") for (int ii = 0; ii < VI; ++ii) { const int idx = tid + NT * ii; const int row = idx / VCH, ch = idx % VCH; \
            const int fsw = (DV == 128) ? ((row & 3) | (((row >> 3) & 1) << 2)) : (((row >> 1) & 1) | (((row >> 3) & 1) << 1)); \
            *(LAS u32x4*)(lds + (stg) * STG + KB + row * VROW + ((((ch >> 1) ^ fsw)) << 5) + (ch & 1) * 16) = vreg[ii]; } } while (0)
#define FA_QK(stg) do { const LAS unsigned char* kb_ = lds + (stg) * STG; \
        _Pragma("unroll") for (int ks = 0; ks < NKS; ++ks) \
        _Pragma("unroll") for (int kt = 0; kt < 4; ++kt) { const int krow = 32 * (kt >> 1) + 8 * (i16 >> 2) + 4 * (kt & 1) + (i16 & 3); \
            const bf16x8 a = *(const LAS bf16x8*)(kb_ + krow * (PK * 2) + (32 * ks + 8 * g) * 2); \
            const bf16x8 a1 = TWO ? *(const LAS bf16x8*)(kb_ + krow * (PK * 2) + (DQK + 32 * ks + 8 * g) * 2) : a; \
            s[kt][0] = MFMA16(a, qf[0][ks], ks == 0 ? negm[0] : s[kt][0]); s[kt][1] = MFMA16(a1, qf[1][ks], ks == 0 ? negm[1] : s[kt][1]); } } while (0)
#define FA_MAXCHK(T) do { if (((T) < 2) || (((T) & 3) == 0)) { \
        _Pragma("unroll") for (int qt = 0; qt < 2; ++qt) { float mx = s[0][qt][0]; \
            _Pragma("unroll") for (int kt = 0; kt < 4; ++kt) _Pragma("unroll") for (int r = 0; r < 4; ++r) mx = fmaxf(mx, s[kt][qt][r]); \
            mx = xmax32(xmax16(mx)); const bool grow = ((T) == 0) || (mx > 8.0f); \
            if (__builtin_amdgcn_ballot_w64(grow)) { const float dl = grow ? mx : 0.f, al = __builtin_amdgcn_exp2f(-dl); lacc[qt] = lacc[qt] * al; \
                _Pragma("unroll") for (int kt = 0; kt < 4; ++kt) s[kt][qt] = s[kt][qt] - dl; \
                _Pragma("unroll") for (int et = 0; et < NET; ++et) o[et][qt] = o[et][qt] * al; \
                pf[0][qt] = scale8(pf[0][qt], al); pf[1][qt] = scale8(pf[1][qt], al);        \
                negm[qt] = negm[qt] - dl; } } } } while (0)
#define FA_EXP4(kt, qt) do { s[kt][qt][0] = __builtin_amdgcn_exp2f(s[kt][qt][0]); s[kt][qt][1] = __builtin_amdgcn_exp2f(s[kt][qt][1]); s[kt][qt][2] = __builtin_amdgcn_exp2f(s[kt][qt][2]); s[kt][qt][3] = __builtin_amdgcn_exp2f(s[kt][qt][3]); } while (0)
    const int vq = i16 >> 2; const int vsw = ((DV == 128) ? (vq | ((g & 1) << 2)) : (((vq >> 1) & 1) | ((g & 1) << 1))) << 5;
    f32x4 s[4][2];
    bf16x8 pf[2][2] = {{(bf16x8){0, 0, 0, 0, 0, 0, 0, 0}, (bf16x8){0, 0, 0, 0, 0, 0, 0, 0}}, {(bf16x8){0, 0, 0, 0, 0, 0, 0, 0}, (bf16x8){0, 0, 0, 0, 0, 0, 0, 0}}};
    FA_GLOADK(0, kr0); FA_LWRITEK(1, kr0);
    FA_GLOADK(1, kr0); FA_GLOADV(0, vr0); FA_LWRITEK(0, kr0); FA_LWRITEV(0, vr0);
    FA_GLOADK(2, kr0); FA_GLOADV(1, vr0);
    FA_BAR();
    FA_QK(1);
    FA_MAXCHK(0);
#pragma unroll
    for (int qt = 0; qt < 2; ++qt) {
#pragma unroll
        for (int kt = 0; kt < 4; ++kt) FA_EXP4(kt, qt);
        pf[0][qt] = pack8(s[0][qt], s[1][qt]); pf[1][qt] = pack8(s[2][qt], s[3][qt]); }
    FA_BAR();
#define FA_STEP(t, KR, VR) do { \
        const LAS unsigned char* vb = lds + ((t) & 1) * STG + KB; \
        bf16x8 va[NET]; \
        _Pragma("unroll") for (int et = 0; et < NET; ++et) va[et] = tr2(vb + (8 * g + vq) * VROW + ((et << 5) ^ vsw) + (lane & 3) * 8, 4 * VROW); \
        FA_LWRITEK(((t) + 1) & 1, KR); FA_LWRITEV(((t) + 1) & 1, VR);        \
        FA_GLOADK((t) + 3, KR); FA_GLOADV((t) + 2, VR);                        \
        FA_QK((t) & 1);                                                        \
        const bool more = (t) + 1 < nkt; \
        if (more) FA_MAXCHK((t) + 1); \
        __builtin_amdgcn_sched_barrier(0); \
        _Pragma("unroll") for (int j = 0; j < 2 * NET; ++j) {        \
            const int et = j % NET, sI = j / NET; \
            o[et][0] = MFMA16(va[et], pf[sI][0], o[et][0]); o[et][1] = MFMA16(va[et], pf[sI][1], o[et][1]); \
            if (sI == 0) va[et] = tr2(vb + (32 + 8 * g + vq) * VROW + ((et << 5) ^ vsw) + (lane & 3) * 8, 4 * VROW); \
            _Pragma("unroll") for (int e = 0; e < EPP; ++e) { const int v = j * EPP + e; s[(v & 15) >> 2][v >> 4][v & 3] = __builtin_amdgcn_exp2f(s[(v & 15) >> 2][v >> 4][v & 3]); } \
            if (j == NET - 1) { lacc[0] = MFMA16(ones, pf[0][0], lacc[0]); lacc[1] = MFMA16(ones, pf[0][1], lacc[1]); } \
            if (j == NET) pf[0][0] = pack8(s[0][0], s[1][0]);                \
            if (j == (NET == 8 ? 12 : 6)) pf[0][1] = pack8(s[0][1], s[1][1]); \
            __builtin_amdgcn_sched_barrier(0); } \
        lacc[0] = MFMA16(ones, pf[1][0], lacc[0]); lacc[1] = MFMA16(ones, pf[1][1], lacc[1]); \
        __builtin_amdgcn_sched_barrier(0); \
        pf[1][0] = pack8(s[2][0], s[3][0]); pf[1][1] = pack8(s[2][1], s[3][1]); \
        FA_BAR(); \
    } while (0)
    for (int t = 0; t < nkt; ++t) { FA_STEP(t, kr0, vr0); }
#undef FA_GLOADK
#undef FA_GLOADV
#undef FA_LWRITEK
#undef FA_LWRITEV
#undef FA_QK
#undef FA_STEP
#undef FA_MAXCHK
#undef FA_EXP4
    if (TWO) {
        const float i0 = 1.0f / lacc[0][0], i1 = lam / lacc[1][0]; float ss = 0.f;
#pragma unroll
        for (int et = 0; et < NET; ++et) { o[et][0] = o[et][0] * i0 - o[et][1] * i1; ss += (o[et][0][0] * o[et][0][0] + o[et][0][1] * o[et][0][1]) + (o[et][0][2] * o[et][0][2] + o[et][0][3] * o[et][0][3]); }
        ss = xsum32(xsum16(ss));
        const float scl = rsqrtf(ss * (1.0f / (float)DV) + EPSF) * osc; const size_t ro = (size_t)(16 * w + i16) * opitch;
#pragma unroll
        for (int et = 0; et < NET; ++et) { const f32x4 v = o[et][0] * scl; u32x2 pw; pw.x = cvt_pk_bf16(v[0], v[1]); pw.y = cvt_pk_bf16(v[2], v[3]); *(u32x2*)((bf16_t*)Out + ro + 16 * et + 4 * g) = pw; }
        return;
    }
#pragma unroll
    for (int qt = 0; qt < 2; ++qt) {
        const float lt = lacc[qt][0];
        const float inv = 1.0f / lt; const size_t ro = (size_t)(32 * w + 16 * qt + i16) * opitch;
#pragma unroll
        for (int et = 0; et < NET; ++et) { const f32x4 v = o[et][qt] * inv;
            if (OUT_BF16) { u32x2 pw; pw.x = cvt_pk_bf16(v[0], v[1]); pw.y = cvt_pk_bf16(v[2], v[3]); *(u32x2*)((bf16_t*)Out + ro + 16 * et + 4 * g) = pw; }
            else *(f32x4*)((float*)Out + ro + 16 * et + 4 * g) = v; }
    }
}
constexpr int RPK = 72 * 2, RPV = 136 * 2;
__device__ __forceinline__ void ret_local_unit(LAS unsigned char* lds, const bf16_t* __restrict__ raw, int cg, int h, float lf2, float lb2, float* __restrict__ U) {
    int tid = threadIdx.x; asm volatile("" : "+v"(tid)); const int lane = tid & 63, w = tid >> 6, g = lane >> 4, i16 = lane & 15;
    LAS unsigned char* Kf = lds; LAS unsigned char* Kb = lds + 128 * RPK; LAS unsigned char* Vl = lds + 2 * 128 * RPK;
    const bf16_t* base = raw + (size_t)cg * 128 * NINP;
#pragma unroll
    for (int ii = 0; ii < 2; ++ii) { const int idx = tid + NT * ii, row = idx >> 3, ch = idx & 7;
        const u32x4 kv = *(const u32x4*)(base + (size_t)row * NINP + 256 + h * 64 + ch * 8);
        const float zf = __builtin_amdgcn_exp2f((float)(127 - row) * lf2), zb = __builtin_amdgcn_exp2f((float)row * lb2);
        u32x4 a, b;
        a.x = cvt_pk_bf16(bf_lo(kv.x) * zf, bf_hi(kv.x) * zf); a.y = cvt_pk_bf16(bf_lo(kv.y) * zf, bf_hi(kv.y) * zf); a.z = cvt_pk_bf16(bf_lo(kv.z) * zf, bf_hi(kv.z) * zf); a.w = cvt_pk_bf16(bf_lo(kv.w) * zf, bf_hi(kv.w) * zf);
        b.x = cvt_pk_bf16(bf_lo(kv.x) * zb, bf_hi(kv.x) * zb); b.y = cvt_pk_bf16(bf_lo(kv.y) * zb, bf_hi(kv.y) * zb); b.z = cvt_pk_bf16(bf_lo(kv.z) * zb, bf_hi(kv.z) * zb); b.w = cvt_pk_bf16(bf_lo(kv.w) * zb, bf_hi(kv.w) * zb);
        *(LAS u32x4*)(Kf + row * RPK + ch * 16) = a; *(LAS u32x4*)(Kb + row * RPK + ch * 16) = b; }
#pragma unroll
    for (int ii = 0; ii < 4; ++ii) { const int idx = tid + NT * ii, row = idx >> 4, ch = idx & 15;
        *(LAS u32x4*)(Vl + row * RPV + ch * 16) = *(const u32x4*)(base + (size_t)row * NINP + 512 + h * 128 + ch * 8); }
    __syncthreads();
    f32x4 af[4], ab[4];
#pragma unroll
    for (int dt = 0; dt < 4; ++dt) { af[dt] = (f32x4){0.f, 0.f, 0.f, 0.f}; ab[dt] = (f32x4){0.f, 0.f, 0.f, 0.f}; }
#pragma unroll
    for (int s = 0; s < 4; ++s) { const int r0 = 32 * s + 8 * g + (i16 >> 2), c4 = 4 * (lane & 3);
        const bf16x8 a = tr2(Vl + r0 * RPV + (16 * w + c4) * 2, 4 * RPV);
#pragma unroll
        for (int dt = 0; dt < 4; ++dt) { const bf16x8 bf = tr2(Kf + r0 * RPK + (16 * dt + c4) * 2, 4 * RPK), bb = tr2(Kb + r0 * RPK + (16 * dt + c4) * 2, 4 * RPK);
            af[dt] = MFMA16(a, bf, af[dt]); ab[dt] = MFMA16(a, bb, ab[dt]); } }
    float* uf = U + ((size_t)(0 * 64 + cg) * 4 + h) * 8192; float* ub = U + ((size_t)(1 * 64 + cg) * 4 + h) * 8192;
#pragma unroll
    for (int dt = 0; dt < 4; ++dt) { const int off = (16 * dt + i16) * 128 + 16 * w + 4 * g; *(f32x4*)(uf + off) = af[dt]; *(f32x4*)(ub + off) = ab[dt]; }
    __syncthreads();
}
__device__ __forceinline__ void ret_out_unit(LAS unsigned char* lds, const bf16_t* __restrict__ raw, int cg, int h, float lf2, float lb2, const float* __restrict__ SIN, bf16_t* __restrict__ yret) {
    int tid = threadIdx.x; asm volatile("" : "+v"(tid)); const int lane = tid & 63, w = tid >> 6, g = lane >> 4, i16 = lane & 15;
    LAS unsigned char* Ql = lds; LAS unsigned char* Kl = lds + 128 * RPK; LAS unsigned char* Vl = lds + 2 * 128 * RPK; LAS unsigned char* Sfl = Vl + 128 * RPV; LAS unsigned char* Sbl = Sfl + 64 * RPV;
    const bf16_t* base = raw + (size_t)cg * 128 * NINP;
#pragma unroll
    for (int ii = 0; ii < 2; ++ii) { const int idx = tid + NT * ii, row = idx >> 3, ch = idx & 7;
        *(LAS u32x4*)(Ql + row * RPK + ch * 16) = *(const u32x4*)(base + (size_t)row * NINP + h * 64 + ch * 8);
        *(LAS u32x4*)(Kl + row * RPK + ch * 16) = *(const u32x4*)(base + (size_t)row * NINP + 256 + h * 64 + ch * 8); }
#pragma unroll
    for (int ii = 0; ii < 4; ++ii) { const int idx = tid + NT * ii, row = idx >> 4, ch = idx & 15;
        *(LAS u32x4*)(Vl + row * RPV + ch * 16) = *(const u32x4*)(base + (size_t)row * NINP + 512 + h * 128 + ch * 8); }
    const float* sf = SIN + ((size_t)(0 * 64 + cg) * 4 + h) * 8192; const float* sb = SIN + ((size_t)(1 * 64 + cg) * 4 + h) * 8192;
#pragma unroll
    for (int ii = 0; ii < 4; ++ii) { const int i4 = (tid + NT * ii) * 4, d = i4 >> 7, e = i4 & 127;
        const f32x4 a = *(const f32x4*)(sf + i4), b = *(const f32x4*)(sb + i4);
        u32x2 pa, pb; pa.x = cvt_pk_bf16(a[0], a[1]); pa.y = cvt_pk_bf16(a[2], a[3]); pb.x = cvt_pk_bf16(b[0], b[1]); pb.y = cvt_pk_bf16(b[2], b[3]);
        *(LAS u32x2*)(Sfl + d * RPV + e * 2) = pa; *(LAS u32x2*)(Sbl + d * RPV + e * 2) = pb; }
    __syncthreads();
    const int il = 16 * w + i16;
    bf16x8 qf[2];
#pragma unroll
    for (int ks = 0; ks < 2; ++ks) qf[ks] = *(const LAS bf16x8*)(Ql + il * RPK + (32 * ks + 8 * g) * 2);
    f32x4 o[8];
#pragma unroll
    for (int et = 0; et < 8; ++et) o[et] = (f32x4){0.f, 0.f, 0.f, 0.f};
    const int c4 = 4 * (lane & 3);
#pragma unroll
    for (int jb = 0; jb < 2; ++jb) {
        f32x4 st[4];
#pragma unroll
        for (int kt = 0; kt < 4; ++kt) st[kt] = (f32x4){0.f, 0.f, 0.f, 0.f};
#pragma unroll
        for (int ks = 0; ks < 2; ++ks)
#pragma unroll
            for (int kt = 0; kt < 4; ++kt) { const int krow = 64 * jb + 32 * (kt >> 1) + 8 * (i16 >> 2) + 4 * (kt & 1) + (i16 & 3);
                st[kt] = MFMA16(*(const LAS bf16x8*)(Kl + krow * RPK + (32 * ks + 8 * g) * 2), qf[ks], st[kt]); }
#pragma unroll
        for (int kt = 0; kt < 4; ++kt)
#pragma unroll
            for (int r = 0; r < 4; ++r) { const int j = 64 * jb + 32 * (kt >> 1) + 8 * g + 4 * (kt & 1) + r; const int df = il - j;
                const float wgt = df >= 0 ? __builtin_amdgcn_exp2f((float)df * lf2) : __builtin_amdgcn_exp2f((float)(-df) * lb2); st[kt][r] *= wgt; }
        const bf16x8 p0 = pack8(st[0], st[1]), p1 = pack8(st[2], st[3]);
#pragma unroll
        for (int et = 0; et < 8; ++et) {
            o[et] = MFMA16(tr2(Vl + (64 * jb + 8 * g + (i16 >> 2)) * RPV + (16 * et + c4) * 2, 4 * RPV), p0, o[et]);
            o[et] = MFMA16(tr2(Vl + (64 * jb + 32 + 8 * g + (i16 >> 2)) * RPV + (16 * et + c4) * 2, 4 * RPV), p1, o[et]); }
    }
    const float xif = __builtin_amdgcn_exp2f((float)(il + 1) * lf2), xib = __builtin_amdgcn_exp2f((float)(128 - il) * lb2);
#pragma unroll
    for (int et = 0; et < 8; ++et) {
        f32x4 tf = (f32x4){0.f, 0.f, 0.f, 0.f}, tb = (f32x4){0.f, 0.f, 0.f, 0.f};
#pragma unroll
        for (int ks = 0; ks < 2; ++ks) { const int r0 = 32 * ks + 8 * g + (i16 >> 2);
            tf = MFMA16(tr2(Sfl + r0 * RPV + (16 * et + c4) * 2, 4 * RPV), qf[ks], tf);
            tb = MFMA16(tr2(Sbl + r0 * RPV + (16 * et + c4) * 2, 4 * RPV), qf[ks], tb); }
        o[et] = o[et] + tf * xif + tb * xib;
    }
    float sm = 0.f;
#pragma unroll
    for (int et = 0; et < 8; ++et) sm += (o[et][0] + o[et][1]) + (o[et][2] + o[et][3]);
    sm += __shfl_xor(sm, 16); sm += __shfl_xor(sm, 32);
    const float mean = sm * (1.0f / 128.0f); float vs = 0.f;
#pragma unroll
    for (int et = 0; et < 8; ++et) { const f32x4 d = o[et] - mean; vs += (d[0] * d[0] + d[1] * d[1]) + (d[2] * d[2] + d[3] * d[3]); }
    vs += __shfl_xor(vs, 16); vs += __shfl_xor(vs, 32);
    const float rstd = rsqrtf(vs * (1.0f / 128.0f) + EPSF);
    const size_t row = (size_t)cg * 128 + il;
    u32x2 rgv[8];
#pragma unroll
    for (int et = 0; et < 8; ++et) rgv[et] = *(const u32x2*)(raw + row * NINP + 1024 + h * 128 + 16 * et + 4 * g);
#pragma unroll
    for (int et = 0; et < 8; ++et) { const int e = 16 * et + 4 * g;
        const u32x2 rg = rgv[et];
        const f32x4 y = (o[et] - mean) * rstd;
        u32x2 pw; pw.x = cvt_pk_bf16(siluf_(bf_lo(rg.x)) * y[0], siluf_(bf_hi(rg.x)) * y[1]); pw.y = cvt_pk_bf16(siluf_(bf_lo(rg.y)) * y[2], siluf_(bf_hi(rg.y)) * y[3]);
        *(u32x2*)(yret + row * 512 + h * 128 + e) = pw; }
    __syncthreads();
}
#define XB_TMO      128
#define XB_XCNT(j)  (256  + 64 * (j))
#define XB_XSUB(j)  (1280 + 64 * (j))
#define XB_XGEN(j)  (2304 + 64 * (j))
#define XB_TOP      3328
#define XB_TOPGEN   3392
#define XCD_BAR_WORDS 3456
#define XB_SPIN_CAP (1u << 18)

__device__ __forceinline__ unsigned xb_ld(unsigned* p)              { return __hip_atomic_load(p, __ATOMIC_RELAXED, __HIP_MEMORY_SCOPE_AGENT); }
__device__ __forceinline__ unsigned xb_add(unsigned* p, unsigned v) { return __hip_atomic_fetch_add(p, v, __ATOMIC_RELAXED, __HIP_MEMORY_SCOPE_AGENT); }
__device__ __forceinline__ unsigned xb_xcc_id() { return (unsigned)__builtin_amdgcn_s_getreg((3 << 11) | 20) & 0xFu; }
#define XB_SPIN(cond, bar) do { unsigned _sp = 0; while (cond) { __builtin_amdgcn_s_sleep(1); \
    if ((++_sp & 255u) == 0u) { if (xb_ld(&(bar)[XB_TMO])) break; if (_sp > XB_SPIN_CAP) { atomicAdd(&(bar)[XB_TMO], 1u); break; } } } } while (0)

struct XcdBarrier {
    unsigned* bar; unsigned x;
    volatile LAS unsigned* st;
};

__device__ __forceinline__ XcdBarrier xcd_barrier_post(unsigned* bar, volatile LAS unsigned* st) {
    XcdBarrier b; b.bar = bar; b.x = xb_xcc_id(); b.st = st;
    if (threadIdx.x == 0) (void)xb_add(&bar[XB_XCNT(b.x)], 1u);
    return b;
}
__device__ __forceinline__ void xcd_barrier_complete(unsigned* bar, unsigned x, unsigned& nloc, unsigned& nx) {
    const unsigned G = gridDim.x * gridDim.y * gridDim.z;
    unsigned sum, cnt, mine, sp = 0u;
    for (;;) {
        sum = 0u; cnt = 0u; mine = 0u;
#pragma unroll
        for (unsigned j = 0; j < 16; ++j) { const unsigned c = xb_ld(&bar[XB_XCNT(j)]); sum += c; cnt += (c > 0u) ? 1u : 0u; mine = (j == x) ? c : mine; }
        if (sum == G) break;
        __builtin_amdgcn_s_sleep(1);
        if ((++sp & 255u) == 0u) { if (xb_ld(&bar[XB_TMO])) break; if (sp > XB_SPIN_CAP) { atomicAdd(&bar[XB_TMO], 1u); break; } }
    }
    nloc = mine > 0u ? mine : 1u; nx = cnt > 0u ? cnt : 1u;
}

__device__ __forceinline__ void xcd_barrier(const XcdBarrier& b) {
    asm volatile("s_waitcnt vmcnt(0)" ::: "memory");
    __syncthreads();
    if (threadIdx.x == 0) {
        unsigned* bar = b.bar;
        __builtin_amdgcn_s_waitcnt(0);
        unsigned nloc = b.st[0], nx = b.st[1];
        if (nloc == 0u) { xcd_barrier_complete(bar, b.x, nloc, nx); b.st[0] = nloc; b.st[1] = nx; }
        const unsigned old = xb_add(&bar[XB_XSUB(b.x)], 1u);
        const unsigned gen = old / nloc;
        if (old + 1u == (gen + 1u) * nloc) {
            __builtin_amdgcn_fence(__ATOMIC_RELEASE, "agent");
            asm volatile("s_waitcnt vmcnt(0)" ::: "memory");
            const unsigned og = xb_add(&bar[XB_TOP], 1u);
            const unsigned tg = og / nx;
            if (og + 1u == (tg + 1u) * nx) xb_add(&bar[XB_TOPGEN], 1u);
            else XB_SPIN(xb_ld(&bar[XB_TOPGEN]) == tg, bar);
            __builtin_amdgcn_fence(__ATOMIC_ACQUIRE, "agent");
            xb_add(&bar[XB_XGEN(b.x)], 1u);
            asm volatile("s_waitcnt vmcnt(0)" ::: "memory");
        } else {
            XB_SPIN(xb_ld(&bar[XB_XGEN(b.x)]) == gen, bar);
            __builtin_amdgcn_fence(__ATOMIC_ACQUIRE, "agent");
            asm volatile("s_waitcnt vmcnt(0)" ::: "memory");
        }
    }
    __syncthreads();
}

typedef const __attribute__((address_space(4))) Params KParams;
#define ENV \
    int phv = ph; asm volatile("" : "+s"(phv)); \
    KParams* pk = (KParams*)__builtin_amdgcn_kernarg_segment_ptr(); asm volatile("" : "+s"(pk)); \
    int tid = threadIdx.x; asm volatile("" : "+v"(tid)); \
    const int lane = tid & 63, wave = __builtin_amdgcn_readfirstlane(tid >> 6); \
    int G = gridDim.x, bx = blockIdx.x; asm volatile("" : "+s"(G), "+s"(bx)); \
    const int vcu = (G % 8 == 0) ? (bx % 8) * (G / 8) + bx / 8 : bx; \
    const int gw = vcu * 8 + wave, NGW = G * 8; \
    unsigned char* ws = pk->ws; \
    float* modv = (float*)(ws + WS_MOD); float* lamv = (float*)(ws + WS_LAM); \
    float* cos64 = (float*)(ws + WS_ROPE); float* sin64 = cos64 + 4096 * 32; float* cos32 = sin64 + 4096 * 32; float* sin32 = cos32 + 4096 * 16; \
    bf16_t* ABUF = (bf16_t*)(ws + WS_ABUF); bf16_t* RAW = (bf16_t*)(ws + WS_RAW); bf16_t* CQN = (bf16_t*)(ws + WS_CQN); bf16_t* CKVN = (bf16_t*)(ws + WS_CKVN); \
    bf16_t* KPE = (bf16_t*)(ws + WS_KPE); bf16_t* QMLA = (bf16_t*)(ws + WS_QMLA); bf16_t* KVMLA = (bf16_t*)(ws + WS_KVMLA); bf16_t* DKV = (bf16_t*)(ws + WS_DKV); \
    float* ODIFF = (float*)(ws + WS_ODIFF); bf16_t* YALL = (bf16_t*)(ws + WS_YALL); float* UST = (float*)(ws + WS_U); float* SIN = (float*)(ws + WS_SIN); bf16_t* HID = (bf16_t*)(ws + WS_HID); bf16_t* BRG = (bf16_t*)(ws + WS_BRG); (void)BRG; \
    float* xres = pk->out + OUT_YP; \
    (void)lane; (void)gw; (void)NGW; (void)modv; (void)lamv; (void)cos64; (void)sin64; (void)cos32; (void)sin32; (void)ABUF; (void)RAW; (void)CQN; (void)CKVN; (void)KPE; (void)QMLA; (void)KVMLA; (void)DKV; \
    (void)ODIFF; (void)YALL; (void)UST; (void)SIN; (void)HID; (void)xres; (void)vcu;
#define LAYER_ENV \
    const int q_ = phv - 1, l = q_ / 36, rr_ = q_ % 36; (void)rr_; \
    unsigned char* wl = ws + WS_W + (size_t)l * WL_STRIDE; const float* modl = modv + l * 9 * 6144; \
    const float* xs0 = l == 0 ? pk->in[0] : xres; const float* xs1 = l == 0 ? pk->in[1] - (size_t)NPR * DM : xres; (void)wl; (void)modl; (void)xs0; (void)xs1;
#define CHUNK_ENV \
    const int ck = rr_ == 31 ? 4 : (rr_ - 1) / 6; const bool prompt = ck == 0; \
    const int row0 = ck * CHR, b0 = prompt ? 0 : 2 * (ck - 1), SEQL = prompt ? 256 : 4096, LK = prompt ? 256 : 4608, PAST = prompt ? 0 : 512, KVR = prompt ? 8192 : 9216, NCH = SEQL / 128, NQB = SEQL / 256; \
    (void)row0; (void)b0; (void)SEQL; (void)LK; (void)PAST; (void)KVR; (void)NCH; (void)NQB;
#define LGF(h) (lamv[8 + l * 8 + (h)])
#define LGB(h) (lamv[8 + l * 8 + 4 + (h)])

#define SUM3(a_, b_, c_) cvt_pk_bf16(bf_lo(a_) + bf_lo(b_) + bf_lo(c_), bf_hi(a_) + bf_hi(b_) + bf_hi(c_))
#define SUM_ROWS(w0_, wn_, dstrow0_) do { \
        for (int r = (w0_); r < CHR; r += (wn_)) { const size_t off = (size_t)r * 1024 + 8 * lane; \
            const u32x4 a0 = *(const u32x4*)(BRG + off), b0 = *(const u32x4*)(BRG + (size_t)CHR * 1024 + off), c0 = *(const u32x4*)(BRG + (size_t)2 * CHR * 1024 + off); \
            const u32x4 a1 = *(const u32x4*)(BRG + off + 512), b1 = *(const u32x4*)(BRG + (size_t)CHR * 1024 + off + 512), c1 = *(const u32x4*)(BRG + (size_t)2 * CHR * 1024 + off + 512); \
            u32x4 w0, w1; w0.x = SUM3(a0.x, b0.x, c0.x); w0.y = SUM3(a0.y, b0.y, c0.y); w0.z = SUM3(a0.z, b0.z, c0.z); w0.w = SUM3(a0.w, b0.w, c0.w); \
            w1.x = SUM3(a1.x, b1.x, c1.x); w1.y = SUM3(a1.y, b1.y, c1.y); w1.z = SUM3(a1.z, b1.z, c1.z); w1.w = SUM3(a1.w, b1.w, c1.w); \
            *(u32x4*)(ABUF + (size_t)(dstrow0_) * DM + off) = w0; *(u32x4*)(ABUF + (size_t)(dstrow0_) * DM + off + 512) = w1; } } while (0)
__global__ void __launch_bounds__(NT, 2) fwd_megakernel(Params p_unused) {
    extern __shared__ __attribute__((aligned(16))) unsigned char lds_raw[];
    LAS unsigned char* lds = (LAS unsigned char*)lds_raw;
    cg::grid_group grid = cg::this_grid();
    if (threadIdx.x < 32) ((volatile LAS unsigned*)(lds + MISC_OFF))[threadIdx.x] = 0u;
    __syncthreads();
    { KParams* pk0 = (KParams*)__builtin_amdgcn_kernarg_segment_ptr(); (void)xcd_barrier_post((unsigned*)(pk0->ws + WS_CTL), (volatile LAS unsigned*)(lds + MISC_OFF) + 8); }
    for (int ph = 0; ph < 74; ++ph) {
        int kind;
        if (ph == 0) kind = 0; else if (ph == 73) kind = 13; else { const int r = (ph - 1) % 36; const int ci = (r - 1) % 6; kind = r == 0 ? 1 : r <= 30 ? (ci == 5 ? 8 : 2 + ci) : r == 31 ? 14 : 9 + (r - 32); }
        if (kind == 0) { ENV
        for (int prb_ = 0; prb_ < PROBE_EW_REPS; ++prb_) {
        LAS float* sl = (LAS float*)lds; LAS float* red = (LAS float*)(lds + 40960);
        for (int blk = bx; blk < 192; blk += G) {
            const int l = blk / 96, n0 = (blk % 96) * 64;
            for (int i = tid; i < 9 * 1024; i += NT) { const int r = i >> 10, k = i & 1023; const float cv = r == 0 ? pk->in[9][k] : pk->in[8][(r - 1) * 1024 + k]; sl[i] = siluf_(cv); }
            __syncthreads();
            const int col = n0 + (tid & 63), ks = tid >> 6;
            float acc[9];
#pragma unroll
            for (int r = 0; r < 9; ++r) acc[r] = 0.f;
            const float* wa = pk->in[12] + (size_t)l * 1024 * 6144 + col;
#pragma unroll 16
            for (int k = ks * 128; k < ks * 128 + 128; ++k) { const float wv = wa[(size_t)k * 6144];
#pragma unroll
                for (int r = 0; r < 9; ++r) acc[r] += sl[r * 1024 + k] * wv; }
#pragma unroll
            for (int r = 0; r < 9; ++r) red[(ks * 9 + r) * 64 + (tid & 63)] = acc[r];
            __syncthreads();
            for (int i = tid; i < 9 * 64; i += NT) { const int r = i >> 6, cc = i & 63; float s = pk->in[13][l * 6144 + n0 + cc];
#pragma unroll
                for (int q = 0; q < 8; ++q) s += red[(q * 9 + r) * 64 + cc];
                modv[(l * 9 + r) * 6144 + n0 + cc] = s; }
            __syncthreads();
        }
        if (bx == 0 && tid < 2) { const int l = tid; const float* dl = pk->in[17] + l * 256; float s1 = 0.f, s2 = 0.f;
            for (int i = 0; i < 64; ++i) { s1 += dl[i] * dl[64 + i]; s2 += dl[128 + i] * dl[192 + i]; }
            const float li = l == 0 ? 0.2f : 0.8f - 0.6f * 0.74081822068171786f;
            lamv[l] = __expf(s1) - __expf(s2) + li; lamv[2 + l] = li;
            float df[4], db[4];
            for (int h = 0; h < 4; ++h) { df[h] = pk->in[15][l * 4 + h]; db[h] = pk->in[16][l * 4 + h]; }
            for (int h = 0; h < 4; ++h) { lamv[8 + l * 8 + h] = -__logf(1.0f + __expf(-df[h])) * L2E; lamv[8 + l * 8 + 4 + h] = -__logf(1.0f + __expf(-db[h])) * L2E; } }
        for (int i = bx * NT + tid; i < 4096 * 48; i += G * NT) {
            int pos, dd, nf; float* cd; float* sd;
            if (i < 4096 * 32) { pos = i >> 5; dd = i & 31; nf = 16; cd = cos64 + i; sd = sin64 + i; } else { const int j = i - 4096 * 32; pos = j >> 4; dd = j & 15; nf = 8; cd = cos32 + j; sd = sin32 + j; }
            const int f = dd % nf; const float basev = dd < nf ? (float)(pos >> 6) : (float)(pos & 63);
            const float inv = __builtin_amdgcn_exp2f(-(float)f / (float)nf * 13.287712379549449f);
            const float ang = basev * inv; const float kq = rintf(ang * 0.15915494309189535f);
            float r = fmaf(-kq, 6.28125f, ang); r = fmaf(-kq, 1.9353071795864769e-3f, r);
            *cd = __cosf(r); *sd = __sinf(r);
        }
        __syncthreads();
        LAS float* scr = (LAS float*)(lds + wave * 16384);
        constexpr int I_IN = 16 * 213, I_UQ = 6 * 24, I_UKV = 4 * 32, I_BR = 8 * 32, I_OUT = 16 * 32, I_FI = 16 * 176, I_FO = 44 * 32;
        constexpr int I_L = I_IN + I_UQ + I_UKV + 3 * I_BR + I_OUT + I_FI + I_FO;
        for (int it = gw; it < 2 * I_L; it += NGW) {
            const int l = it / I_L; int r = it % I_L; unsigned char* wl = ws + WS_W + (size_t)l * WL_STRIDE;
            if (r < I_IN) { const int kb = r / 213, nb = r % 213; transpose_item(pk->in[14] + (size_t)l * 1024 * 6816, 1024, 6816, (bf16_t*)(wl + WO_IN), 64 * kb, 32 * nb, 32 * nb, scr, lane); continue; } r -= I_IN;
            if (r < I_UQ) { const int kb = r / 24, nb = r % 24; transpose_item(pk->in[20] + (size_t)l * 384 * 768, 384, 768, (bf16_t*)(wl + WO_UQ), 64 * kb, 32 * nb, 32 * nb, scr, lane); continue; } r -= I_UQ;
            if (r < I_UKV) { const int kb = r / 32, nb = r % 32; transpose_item(pk->in[21] + (size_t)l * 256 * 1024, 256, 1024, (bf16_t*)(wl + WO_UKV), 64 * kb, 32 * nb, 32 * nb, scr, lane); continue; } r -= I_UKV;
            if (r < 3 * I_BR) { const int gg = r / I_BR, rr = r % I_BR, kb = rr / 32, nb = rr % 32;
                transpose_item(pk->in[22] + ((size_t)l * 3 + gg) * 512 * 1024, 512, 1024, (bf16_t*)(wl + WO_BR), 64 * kb, 32 * nb, gg * 1024 + 32 * nb, scr, lane); continue; } r -= 3 * I_BR;
            if (r < I_OUT) { const int kb = r / 32, nb = r % 32; transpose_item(pk->in[23] + (size_t)l * 1024 * 1024, 1024, 1024, (bf16_t*)(wl + WO_OUT), 64 * kb, 32 * nb, 32 * nb, scr, lane); continue; } r -= I_OUT;
            if (r < I_FI) { const int kb = r / 176, nb = r % 176; const int n0 = 32 * nb; const int dst = n0 < 2816 ? 256 * (n0 / 128) + (n0 % 128) : 256 * ((n0 - 2816) / 128) + 128 + ((n0 - 2816) % 128);
                transpose_item(pk->in[24] + (size_t)l * 1024 * 5632, 1024, 5632, (bf16_t*)(wl + WO_FI), 64 * kb, n0, dst, scr, lane); continue; } r -= I_FI;
            { const int kb = r / 32, nb = r % 32; transpose_item(pk->in[25] + (size_t)l * 2816 * 1024, 2816, 1024, (bf16_t*)(wl + WO_FO), 64 * kb, 32 * nb, 32 * nb, scr, lane); }
        }
        __syncthreads(); }
        }
        else if (kind == 1) { ENV LAYER_ENV
        for (int prb_ = 0; prb_ < PROBE_EW_REPS; ++prb_)
        for (int m = gw; m < NTOK; m += NGW) {
            const int grp = m < NPR ? 0 : 1 + ((m - NPR) >> 12); const float* xr = (m < NPR ? xs0 : xs1) + (size_t)m * DM; const float* md = modl + grp * 6144; const float* gn = pk->in[10] + l * DM;
            f32x4 v[4]; float ss = 0.f;
#pragma unroll
            for (int j = 0; j < 4; ++j) { v[j] = *(const f32x4*)(xr + 4 * lane + 256 * j); ss += (v[j][0] * v[j][0] + v[j][1] * v[j][1]) + (v[j][2] * v[j][2] + v[j][3] * v[j][3]); }
            const float rstd = rsqrtf(wave_sum(ss) * (1.0f / DM) + EPSF);
#pragma unroll
            for (int j = 0; j < 4; ++j) { const int c = 4 * lane + 256 * j; const f32x4 gg = *(const f32x4*)(gn + c), sh = *(const f32x4*)(md + c), scv = *(const f32x4*)(md + 1024 + c);
                const f32x4 y = v[j] * rstd * gg * (scv + 1.0f) + sh; u32x2 pw; pw.x = cvt_pk_bf16(y[0], y[1]); pw.y = cvt_pk_bf16(y[2], y[3]);
                *(u32x2*)(ABUF + (size_t)m * DM + c) = pw; }
        } }
        else if (kind == 2) { ENV LAYER_ENV CHUNK_ENV
            for (int prg_ = 0; prg_ < PROBE_G1_REPS; ++prg_)
            { pg8::Gemm g{ABUF + (size_t)row0 * DM, (const bf16_t*)(wl + WO_IN), CHR, NCOLA, DM}; pg8::StaticOrder S; S.init(CHR, NCOLA, G, bx); pg8::EpiRaw E{RAW, NINP};

          pg8::gemm_phase<pg8::EpiRaw, pg8::StaticOrder, true, true>(lds, g, S, E);
 }
        }
        else if (kind == 3) { ENV LAYER_ENV CHUNK_ENV
            { pg8::Gemm g{ABUF + (size_t)row0 * DM, (const bf16_t*)(wl + WO_IN) + (size_t)NCOLA * DM, CHR, NINP - NCOLA, DM}; pg8::StaticOrder S; S.init(CHR, NINP - NCOLA, G, bx); pg8::EpiRaw E{RAW + NCOLA, NINP};
              pg8::gemm_phase<pg8::EpiRaw, pg8::StaticOrder, true, true>(lds, g, S, E); }
            const int nun = (CHR / 256) * ((NINP - NCOLA) / 256); const bool split = nun < G;
            const int pw0 = split ? (bx - nun) * 8 + wave : gw, pwn = split ? (G - nun) * 8 : NGW;
            if (!split || bx >= nun) {
            for (int r = pw0; r < CHR + (prompt ? 0 : 1024); r += pwn) {
                if (r < CHR) {
                    bf16_t* rp = RAW + (size_t)r * NINP; const int bb = r / SEQL, s = r % SEQL; const size_t kvrow = (size_t)bb * LK + PAST + s; const size_t orow = ((size_t)bb * 2 + l) * 256 + s;
                    const int dd = lane & 31, hq = lane >> 5;
                    float ra[8], rb[8], ka[4], kb[4], cqv[6], ckvv[4];
#pragma unroll
                    for (int i = 0; i < 8; ++i) { const int head = 2 * i + hq; const int cb = head < 8 ? head * 64 : 1536 + (head - 8) * 64; ra[i] = bf2f(rp[cb + dd]); rb[i] = bf2f(rp[cb + dd + 32]); }
#pragma unroll
                    for (int i = 0; i < 4; ++i) { const int cb = 2048 + (2 * i + hq) * 64; ka[i] = bf2f(rp[cb + dd]); kb[i] = bf2f(rp[cb + dd + 32]); }
                    const u32x4 dv = *(const u32x4*)(rp + 2560 + 8 * lane);
#pragma unroll
                    for (int i = 0; i < 6; ++i) cqv[i] = bf2f(rp[3072 + lane + 64 * i]);
#pragma unroll
                    for (int i = 0; i < 4; ++i) ckvv[i] = bf2f(rp[3456 + lane + 64 * i]);
                    float p1 = bf2f(rp[3712 + (lane & 15)]), p2 = bf2f(rp[3712 + 16 + (lane & 15)]);
                    float c6 = 1.f, s6 = 0.f, c3 = 1.f, s3 = 0.f;
                    if (!prompt) { c6 = cos64[s * 32 + dd]; s6 = sin64[s * 32 + dd]; c3 = cos32[s * 16 + (lane & 15)]; s3 = sin32[s * 16 + (lane & 15)]; }
                    float gq[6], gk[4];
#pragma unroll
                    for (int i = 0; i < 6; ++i) gq[i] = pk->in[18][l * 384 + lane + 64 * i];
#pragma unroll
                    for (int i = 0; i < 4; ++i) gk[i] = pk->in[19][l * 256 + lane + 64 * i];
                    float ssq = 0.f, ssk = 0.f;
#pragma unroll
                    for (int i = 0; i < 6; ++i) ssq += cqv[i] * cqv[i];
#pragma unroll
                    for (int i = 0; i < 4; ++i) ssk += ckvv[i] * ckvv[i];
                    const float rsq = rsqrtf(wave_sum(ssq) * (1.0f / 384.0f) + EPSF), rsk = rsqrtf(wave_sum(ssk) * (1.0f / 256.0f) + EPSF);
#pragma unroll
                    for (int i = 0; i < 8; ++i) { const int head = 2 * i + hq; const int cb = head < 8 ? head * 64 : 1536 + (head - 8) * 64; const float sc = (head >= 4 && head < 8) ? 0.125f : 1.0f;
                        const float x1 = ra[i] * sc, x2 = rb[i] * sc; rp[cb + dd] = f2bf(x1 * c6 - x2 * s6); rp[cb + dd + 32] = f2bf(x2 * c6 + x1 * s6); }
#pragma unroll
                    for (int i = 0; i < 4; ++i) { const int head = 2 * i + hq;
                        if (prompt) { float* od = pk->out + OUT_DK + orow * 512 + head * 64 + dd; od[0] = ka[i]; od[32] = kb[i]; }
                        DKV[kvrow * 1024 + head * 64 + dd] = f2bf(ka[i] * c6 - kb[i] * s6); DKV[kvrow * 1024 + head * 64 + dd + 32] = f2bf(kb[i] * c6 + ka[i] * s6); }
                    *(u32x4*)(DKV + kvrow * 1024 + 512 + 8 * lane) = dv;
                    if (prompt) { float* od = pk->out + OUT_DV + orow * 512 + 8 * lane; *(f32x4*)od = (f32x4){bf_lo(dv.x), bf_hi(dv.x), bf_lo(dv.y), bf_hi(dv.y)}; *(f32x4*)(od + 4) = (f32x4){bf_lo(dv.z), bf_hi(dv.z), bf_lo(dv.w), bf_hi(dv.w)}; }
#pragma unroll
                    for (int i = 0; i < 6; ++i) CQN[(size_t)r * 384 + lane + 64 * i] = f2bf(cqv[i] * rsq * gq[i]);
#pragma unroll
                    for (int i = 0; i < 4; ++i) { const float y = ckvv[i] * rsk * gk[i]; CKVN[kvrow * 256 + lane + 64 * i] = f2bf(y); if (prompt) pk->out[OUT_CKV + orow * 256 + lane + 64 * i] = y; }
                    if (lane < 16) {
                        if (prompt) { pk->out[OUT_KPE + orow * 32 + lane] = p1; pk->out[OUT_KPE + orow * 32 + 16 + lane] = p2; }
                        KPE[kvrow * 32 + lane] = f2bf(p1 * c3 - p2 * s3); KPE[kvrow * 32 + 16 + lane] = f2bf(p2 * c3 + p1 * s3); }
                } else {
                    const int cr = r - CHR, bb = cr >> 9, key = cr & 511; const size_t kvrow = (size_t)bb * LK + key; const size_t crow = ((size_t)(b0 + bb) * 2 + l) * 512 + key;
                    { const float* s0 = pk->in[4] + crow * 512 + 8 * lane; const float* s1 = pk->in[5] + crow * 512 + 8 * lane;
                      const f32x4 a = *(const f32x4*)s0, b = *(const f32x4*)(s0 + 4), c = *(const f32x4*)s1, d = *(const f32x4*)(s1 + 4), e = *(const f32x4*)(pk->in[6] + crow * 256 + 4 * lane);
                      const float kp = pk->in[7][crow * 32 + (lane & 31)];
                      u32x4 w; w.x = cvt_pk_bf16(a[0], a[1]); w.y = cvt_pk_bf16(a[2], a[3]); w.z = cvt_pk_bf16(b[0], b[1]); w.w = cvt_pk_bf16(b[2], b[3]); *(u32x4*)(DKV + kvrow * 1024 + 8 * lane) = w;
                      w.x = cvt_pk_bf16(c[0], c[1]); w.y = cvt_pk_bf16(c[2], c[3]); w.z = cvt_pk_bf16(d[0], d[1]); w.w = cvt_pk_bf16(d[2], d[3]); *(u32x4*)(DKV + kvrow * 1024 + 512 + 8 * lane) = w;
                      u32x2 w2; w2.x = cvt_pk_bf16(e[0], e[1]); w2.y = cvt_pk_bf16(e[2], e[3]); *(u32x2*)(CKVN + kvrow * 256 + 4 * lane) = w2;
                      if (lane < 32) KPE[kvrow * 32 + lane] = f2bf(kp); }
                }
            }
            if (ck > 0) { SUM_ROWS(pw0, pwn, row0 - CHR); }
            } }
        else if (kind == 4) { ENV LAYER_ENV CHUNK_ENV
            for (int prc_ = 0; prc_ < PROBE_C_REPS; ++prc_) {
            { pg8::Gemm g{CQN, (const bf16_t*)(wl + WO_UQ), CHR, 768, 384}; pg8::OffsetOrder S; S.init(CHR, 768, G, bx, 0); pg8::EpiRaw E{QMLA, 768};

          pg8::gemm_phase<pg8::EpiRaw, pg8::OffsetOrder, true, true>(lds, g, S, E);
 }
            { pg8::Gemm g{CKVN, (const bf16_t*)(wl + WO_UKV), KVR, 1024, 256}; pg8::OffsetOrder S; S.init(KVR, 1024, G, bx, 96 % G); pg8::EpiRaw E{KVMLA, 1024};

          pg8::gemm_phase<pg8::EpiRaw, pg8::OffsetOrder, true, true>(lds, g, S, E);
 }
            for (int u = (bx + G - (240 % G)) % G; u < 256; u += G) { const int h = u & 3;
ret_local_unit(lds, RAW, u >> 2, h, LGF(h), LGB(h), UST);
 }
            }
        }
        else if (kind == 5) { ENV LAYER_ENV CHUNK_ENV
            { const int nbat = prompt ? 32 : 2; const int total = nbat * 8 * 8192;
              for (int prb_ = 0; prb_ < PROBE_EW_REPS; ++prb_)
              for (int i = bx * NT + tid; i < total; i += G * NT) { const int e = i & 8191, rest = i >> 13, dir = rest & 1, h = (rest >> 1) & 3, bb = rest >> 3;
                  const float gC = __builtin_amdgcn_exp2f(128.0f * (dir == 0 ? LGF(h) : LGB(h)));
                  const size_t so = (((size_t)(b0 + bb) * 2 + l) * 4 + h) * 8192 + e;
                  float s = prompt ? 0.f : (dir == 0 ? pk->in[2][so] : pk->in[3][so]);
                  if (NCH >= 8) {
                      for (int c0 = 0; c0 < NCH; c0 += 8) { float uu[8]; size_t uo[8];
#pragma unroll
                          for (int k = 0; k < 8; ++k) { const int cc = c0 + k; const int c = dir == 0 ? cc : NCH - 1 - cc; uo[k] = ((size_t)(dir * 64 + bb * NCH + c) * 4 + h) * 8192 + e; uu[k] = UST[uo[k]]; }
#pragma unroll
                          for (int k = 0; k < 8; ++k) { SIN[uo[k]] = s; s = gC * s + uu[k]; } }
                  } else {
                      for (int c0 = 0; c0 < NCH; c0 += 2) { float uu[2]; size_t uo[2];
#pragma unroll
                          for (int k = 0; k < 2; ++k) { const int cc = c0 + k; const int c = dir == 0 ? cc : NCH - 1 - cc; uo[k] = ((size_t)(dir * 64 + bb * NCH + c) * 4 + h) * 8192 + e; uu[k] = UST[uo[k]]; }
#pragma unroll
                          for (int k = 0; k < 2; ++k) { SIN[uo[k]] = s; s = gC * s + uu[k]; } }
                  }
                  if (prompt) pk->out[(dir == 0 ? OUT_RF : OUT_RB) + so] = s; } } }
        else if (kind == 6) { ENV LAYER_ENV CHUNK_ENV
            for (int rep_ = 0; rep_ < PROBE_E_REPS; ++rep_) {
#if PROBE_FA_MODE
            if (!prompt) for (int u = vcu; u < 256; u += G) { const int qb = u % NQB, c = (u / NQB) & 1, h = (u / (2 * NQB)) & 3, bb = u / (8 * NQB); const size_t qrow = (size_t)bb * SEQL + qb * 256;
                fa_unit<64, 128, false, PROBE_FA_MODE>(lds, RAW + qrow * NINP + 1536 + h * 128 + c * 64, NINP, DKV + (size_t)bb * LK * 1024 + h * 128 + c * 64, 1024, nullptr, 0,
                                        DKV + (size_t)bb * LK * 1024 + 512 + h * 128, 1024, LK / 64, 0.125f * L2E, (float*)(ws + 432 * MiB) + ((size_t)c * CHR + qrow) * 512 + h * 128, 512); }
#endif
            { const float lam = lamv[l], lam_init = lamv[2 + l]; const int NQ2 = SEQL / 128;
            for (int u = vcu; u < 256; u += G) { const int qb = u % NQ2, h = (u / NQ2) & 3, bb = u / (4 * NQ2); const size_t qrow = (size_t)bb * SEQL + qb * 128;
                fa_unit<64, 128, true, true>(lds, RAW + qrow * NINP + 1536 + h * 128, NINP, DKV + (size_t)bb * LK * 1024 + h * 128, 1024, nullptr, 0,
                                             DKV + (size_t)bb * LK * 1024 + 512 + h * 128, 1024, LK / 64, 0.125f * L2E, YALL + ((size_t)CHR + qrow) * 512 + h * 128, 512, lam, 1.0f - lam_init); } }
            for (int u = vcu; u < 256; u += G) { const int qb = u % NQB, h = (u / NQB) & 7, bb = u / (8 * NQB); const size_t qrow = (size_t)bb * SEQL + qb * 256;
                fa_unit<96, 64, true>(lds, QMLA + qrow * 768 + h * 96, 768, KVMLA + (size_t)bb * LK * 1024 + h * 128, 1024, KPE + (size_t)bb * LK * 32, 32,
                                      KVMLA + (size_t)bb * LK * 1024 + h * 128 + 64, 1024, LK / 64, 0.10206207261596577f * L2E, YALL + ((size_t)2 * CHR + qrow) * 512 + h * 64, 512, 0.f, 1.f, prompt ? nullptr : cos32, sin32, qb * 256);
 }
            for (int pro_ = 0; pro_ < PROBE_O_REPS; ++pro_)
            for (int u = vcu; u < 256; u += G) { const int h = u & 3;
ret_out_unit(lds, RAW, u >> 2, h, LGF(h), LGB(h), SIN, YALL);
 }
            }
        }
        else if (kind == 7) { ENV LAYER_ENV CHUNK_ENV
            const float lam = lamv[l], lam_init = lamv[2 + l];
            for (int prb_ = 0; prb_ < PROBE_EW_REPS; ++prb_)
            for (int r = gw; r < CHR; r += NGW) {
                const float* o1 = ODIFF + (size_t)r * 512 + 8 * lane; const float* o2 = o1 + (size_t)CHR * 512;
                const f32x4 a0 = *(const f32x4*)o1, a1 = *(const f32x4*)(o1 + 4), b0v = *(const f32x4*)o2, b1v = *(const f32x4*)(o2 + 4);
                const f32x4 d0 = a0 - b0v * lam, d1 = a1 - b1v * lam;
                float ss = (d0[0] * d0[0] + d0[1] * d0[1]) + (d0[2] * d0[2] + d0[3] * d0[3]) + (d1[0] * d1[0] + d1[1] * d1[1]) + (d1[2] * d1[2] + d1[3] * d1[3]);
                ss += __shfl_xor(ss, 1); ss += __shfl_xor(ss, 2); ss += __shfl_xor(ss, 4); ss += __shfl_xor(ss, 8);
                const float sc = rsqrtf(ss * (1.0f / 128.0f) + EPSF) * (1.0f - lam_init);
                u32x4 w; w.x = cvt_pk_bf16(d0[0] * sc, d0[1] * sc); w.y = cvt_pk_bf16(d0[2] * sc, d0[3] * sc); w.z = cvt_pk_bf16(d1[0] * sc, d1[1] * sc); w.w = cvt_pk_bf16(d1[2] * sc, d1[3] * sc);
                *(u32x4*)(YALL + ((size_t)CHR + r) * 512 + 8 * lane) = w;
            } }
        else if (kind == 8) { ENV LAYER_ENV CHUNK_ENV
            for (int prg_ = 0; prg_ < PROBE_G4_REPS; ++prg_)
            { pg8::Gemm g{YALL, (const bf16_t*)(wl + WO_BR), 3 * CHR, 3072, 512}; pg8::GateOrder S{CHR / 256, G, bx}; pg8::EpiGate E{RAW, BRG, CHR / 256};

          pg8::gemm_phase<pg8::EpiGate, pg8::GateOrder, true, true>(lds, g, S, E);
 }
        }
        else if (kind == 9) { ENV LAYER_ENV
        for (int prr_ = 0; prr_ < PROBE_R_REPS; ++prr_)
        { pg8::Gemm g{ABUF, (const bf16_t*)(wl + WO_OUT), NTOK, DM, DM}; pg8::StaticOrder S; S.init(NTOK, DM, G, bx); pg8::EpiResid E{xs0, xs1, xres, modl + 2048, prr_ < PROBE_R_REPS - 1};

          pg8::gemm_phase<pg8::EpiResid, pg8::StaticOrder, true, true>(lds, g, S, E);
 }
        }
        else if (kind == 10) { ENV LAYER_ENV
        for (int prb_ = 0; prb_ < PROBE_EW_REPS; ++prb_)
        for (int m = gw; m < NTOK; m += NGW) {
            const int grp = m < NPR ? 0 : 1 + ((m - NPR) >> 12); const float* xr = xres + (size_t)m * DM; const float* md = modl + grp * 6144; const float* gn = pk->in[11] + l * DM;
            f32x4 v[4]; float ss = 0.f;
#pragma unroll
            for (int j = 0; j < 4; ++j) { v[j] = *(const f32x4*)(xr + 4 * lane + 256 * j); ss += (v[j][0] * v[j][0] + v[j][1] * v[j][1]) + (v[j][2] * v[j][2] + v[j][3] * v[j][3]); }
            const float rstd = rsqrtf(wave_sum(ss) * (1.0f / DM) + EPSF);
#pragma unroll
            for (int j = 0; j < 4; ++j) { const int c = 4 * lane + 256 * j; const f32x4 gg = *(const f32x4*)(gn + c), sh = *(const f32x4*)(md + 3072 + c), scv = *(const f32x4*)(md + 4096 + c);
                const f32x4 y = v[j] * rstd * gg * (scv + 1.0f) + sh; u32x2 pw; pw.x = cvt_pk_bf16(y[0], y[1]); pw.y = cvt_pk_bf16(y[2], y[3]);
                *(u32x2*)(ABUF + (size_t)m * DM + c) = pw; }
        } }
        else if (kind == 11) { ENV LAYER_ENV
            for (int prg_ = 0; prg_ < PROBE_G6_REPS; ++prg_)
        { pg8::Gemm g{ABUF, (const bf16_t*)(wl + WO_FI), NTOK, 5632, DM}; pg8::StaticOrder S; S.init(NTOK, 5632, G, bx); pg8::EpiSwiglu E{HID, 2816};

          pg8::gemm_phase<pg8::EpiSwiglu, pg8::StaticOrder, true, true>(lds, g, S, E);
 }
        }
        else if (kind == 12) { ENV LAYER_ENV
        for (int prr_ = 0; prr_ < PROBE_R_REPS; ++prr_)
        { pg8::Gemm g{HID, (const bf16_t*)(wl + WO_FO), NTOK, DM, 2816}; pg8::StaticOrder S; S.init(NTOK, DM, G, bx); pg8::EpiResid E{xres, xres, xres, modl + 5120, prr_ < PROBE_R_REPS - 1};

          pg8::gemm_phase<pg8::EpiResid, pg8::StaticOrder, true, true>(lds, g, S, E);
 }
        }
        else if (kind == 14) { ENV LAYER_ENV CHUNK_ENV
            SUM_ROWS(gw, NGW, row0);
        }
        else { ENV
    for (int m = gw; m < NTOK; m += NGW) {
        float* xr = xres + (size_t)m * DM; const float* gn = pk->in[26];
        f32x4 v[4]; float ss = 0.f;
#pragma unroll
        for (int j = 0; j < 4; ++j) { v[j] = *(const f32x4*)(xr + 4 * lane + 256 * j); ss += (v[j][0] * v[j][0] + v[j][1] * v[j][1]) + (v[j][2] * v[j][2] + v[j][3] * v[j][3]); }
        const float rstd = rsqrtf(wave_sum(ss) * (1.0f / DM) + EPSF);
        f32x4 gv[4];
#pragma unroll
        for (int j = 0; j < 4; ++j) gv[j] = *(const f32x4*)(gn + 4 * lane + 256 * j);
#pragma unroll
        for (int j = 0; j < 4; ++j) { const int c = 4 * lane + 256 * j; *(f32x4*)(xr + c) = v[j] * rstd * gv[j]; }
    } }
        if (ph != 73) {
            if (ph == 0) { KParams* pkc = (KParams*)__builtin_amdgcn_kernarg_segment_ptr(); if (pkc->out == nullptr) grid.sync(); }
            KParams* pkb = (KParams*)__builtin_amdgcn_kernarg_segment_ptr(); asm volatile("" : "+s"(pkb));
            XcdBarrier xb_; xb_.bar = (unsigned*)(pkb->ws + WS_CTL); xb_.x = xb_xcc_id(); xb_.st = (volatile LAS unsigned*)(lds + MISC_OFF) + 8; for (int rs_ = 0; rs_ < PROBE_SYNC_REPS; ++rs_) xcd_barrier(xb_); }
    }
}

extern "C" void kernel_launch(void* const* d_in, const int* in_sizes, int n_in, void* d_out, int out_size, void* d_ws, size_t ws_size, hipStream_t stream) {
    static int grid = 0;
    if (grid == 0) {
        if (n_in != 27 || (size_t)out_size != OUT_TOTAL || ws_size < WS_END) { fprintf(stderr, "kernel_launch: unexpected shapes (n_in %d out %d ws %zu)\n", n_in, out_size, ws_size); grid = -1; return; }
        int dev = 0, cus = 0, per_cu = 0;
        hipGetDevice(&dev); hipDeviceGetAttribute(&cus, hipDeviceAttributeMultiprocessorCount, dev);
        if (hipFuncSetAttribute((const void*)fwd_megakernel, hipFuncAttributeMaxDynamicSharedMemorySize, LDS_BYTES) != hipSuccess) { fprintf(stderr, "kernel_launch: hipFuncSetAttribute failed\n"); grid = -1; return; }
        if (hipOccupancyMaxActiveBlocksPerMultiprocessor(&per_cu, (const void*)fwd_megakernel, NT, LDS_BYTES) != hipSuccess || per_cu < 1) { fprintf(stderr, "kernel_launch: occupancy query says %d\n", per_cu); per_cu = 1; }
        (void)hipGetLastError();
        grid = cus;
    }
    if (grid < 0) return;
    if (hipMemsetAsync((char*)d_ws + WS_CTL, 0, 65536, stream) != hipSuccess) { fprintf(stderr, "kernel_launch: memset failed\n"); return; }
    Params p{};
    for (int i = 0; i < 27; ++i) p.in[i] = (const float*)d_in[i];
    p.out = (float*)d_out; p.ws = (unsigned char*)d_ws;
    void* args[] = {&p};
    hipError_t e = hipLaunchCooperativeKernel((const void*)fwd_megakernel, dim3(grid), dim3(NT), args, LDS_BYTES, stream);
    if (e != hipSuccess) fprintf(stderr, "cooperative launch failed: %s (grid %d)\n", hipGetErrorString(e), grid);
}
```

```cpp
#include <hip/hip_runtime.h>
#include <hip/hip_cooperative_groups.h>
#include <cstdio>
#include <cstdint>
namespace cg = cooperative_groups;
#ifndef PROBE_E_REPS
#define PROBE_E_REPS 1
#endif
#ifndef PROBE_SYNC_REPS
#define PROBE_SYNC_REPS 1
#endif
#ifndef PROBE_EW_REPS
#define PROBE_EW_REPS 1
#endif
#ifndef PROBE_G1_REPS
#define PROBE_G1_REPS 1
#endif
#ifndef PROBE_G4_REPS
#define PROBE_G4_REPS 1
#endif
#ifndef PROBE_G6_REPS
#define PROBE_G6_REPS 1
#endif
#ifndef PROBE_C_REPS
#define PROBE_C_REPS 1
#endif
#ifndef PROBE_R_REPS
#define PROBE_R_REPS 1
#endif
#ifndef PROBE_D_REPS
#define PROBE_D_REPS 1
#endif
#ifndef PROBE_O_REPS
#define PROBE_O_REPS 1
#endif
#ifndef PROBE_MFMA
#define PROBE_MFMA 0
#endif
#ifndef PROBE_FA_MODE
#define PROBE_FA_MODE 0
#endif
namespace pg8 {
#define PG8_LAS __attribute__((address_space(3)))
typedef unsigned short bf16_t;
typedef short bf16x8 __attribute__((ext_vector_type(8)));
typedef float f32x4 __attribute__((ext_vector_type(4)));
typedef unsigned u32x4 __attribute__((ext_vector_type(4)));
constexpr int BM = 256, BK = 64, HALF = 128, HTB = HALF * BK * 2  , STAGE_BYTES = 8 * HTB, NXCD = 8, WGM = 8;

__host__ __device__ __forceinline__ int lds_byte(int r, int c) { const int st = (r >> 4) * 2 + (c >> 5), rr = r & 15, cc = c & 31, ob = rr * 64 + cc * 2; return st * 1024 + (ob ^ (((ob >> 9) & 1) << 5)); }
__host__ __device__ __forceinline__ void stage_rc(int b, int& R, int& C) { const int st = b / 1024, sb = b % 1024, swz = sb ^ (((sb >> 9) & 1) << 5); R = (st >> 1) * 16 + swz / 64; C = (st & 1) * 32 + (swz % 64) / 2; }
__host__ __device__ __forceinline__ int perm32(int rho) { const int n = rho >> 4, i = rho & 15; return 8 * (i >> 2) + 4 * n + (i & 3); }

struct Unit { int pm, pn; };
struct Gemm { const bf16_t* A; const bf16_t* Bt; int M, N, K; };

struct StaticOrder {
    int nM, nN, nwg, G, c;
    __host__ __device__ void init(int M, int N, int G_, int c_) { nM = M / BM; nN = N / BM; nwg = nM * nN; G = G_; c = c_; }
    __host__ __device__ bool next(int i, Unit& u) const {
        const long L = (long)i * G + c; if (L >= nwg) return false;
        int wgid = (int)L; { const int q = nwg / NXCD, r = nwg % NXCD, xcd = wgid % NXCD, off = wgid / NXCD; wgid = (xcd < r ? xcd * (q + 1) : r * (q + 1) + (xcd - r) * q) + off; }
        const int nig = WGM * nN, gid = wgid / nig, fm = gid * WGM, gsz = (nM - fm) < WGM ? (nM - fm) : WGM;
        u.pm = fm + ((wgid % nig) % gsz); u.pn = (wgid % nig) / gsz; return true;
    }
    __device__ __forceinline__ void a_ready(const Unit&) const {}
    __device__ __forceinline__ void done(const Unit&) const {}
};

typedef float f32x2c_t __attribute__((ext_vector_type(2))); typedef __bf16 bf16x2c_t __attribute__((ext_vector_type(2)));
__device__ __forceinline__ unsigned cvt_pk_bf16(float lo, float hi) { const f32x2c_t v = {lo, hi}; const bf16x2c_t b = __builtin_convertvector(v, bf16x2c_t); return __builtin_bit_cast(unsigned, b); }
typedef float f32x2 __attribute__((ext_vector_type(2)));
typedef unsigned u32x2 __attribute__((ext_vector_type(2)));
__device__ __forceinline__ float bf_lo(unsigned w) { return __uint_as_float(w << 16); }
__device__ __forceinline__ float bf_hi(unsigned w) { return __uint_as_float(w & 0xffff0000u); }
__device__ __forceinline__ float sigmoidf_(float x) { return __builtin_amdgcn_rcpf(1.0f + __expf(-x)); }
__device__ __forceinline__ float siluf_(float x) { return x * __builtin_amdgcn_rcpf(1.0f + __expf(-x)); }

struct EpiRaw {
    static constexpr bool PERM = true, AFTER_DRAIN = false;
    bf16_t* O; int ldc;
    __device__ __forceinline__ void operator()(const f32x4 (&acc)[2][2][4][2], const Unit& u, int wr, int wc, int fr, int fq) const {
        const int row0 = u.pm * BM + wr * 64 + fr, col0 = u.pn * BM + wc * 32 + 8 * fq;
#pragma unroll
        for (int ai = 0; ai < 2; ++ai)
#pragma unroll
            for (int m = 0; m < 4; ++m) { bf16_t* rowp = O + (size_t)(row0 + ai * HALF + m * 16) * ldc + col0;
#pragma unroll
                for (int bj = 0; bj < 2; ++bj) { const f32x4 v0 = acc[ai][bj][m][0], v1 = acc[ai][bj][m][1];
                    u32x4 w; w.x = cvt_pk_bf16(v0[0], v0[1]); w.y = cvt_pk_bf16(v0[2], v0[3]); w.z = cvt_pk_bf16(v1[0], v1[1]); w.w = cvt_pk_bf16(v1[2], v1[3]);
                    *(u32x4*)(rowp + bj * HALF) = w; } }
    }
};
struct EpiSwiglu {
    static constexpr bool PERM = true, AFTER_DRAIN = false;
    bf16_t* O; int ldc;
    __device__ __forceinline__ void operator()(const f32x4 (&acc)[2][2][4][2], const Unit& u, int wr, int wc, int fr, int fq) const {
        const int row0 = u.pm * BM + wr * 64 + fr, col0 = u.pn * HALF + wc * 32 + 8 * fq;
#pragma unroll
        for (int ai = 0; ai < 2; ++ai)
#pragma unroll
            for (int m = 0; m < 4; ++m) { bf16_t* rowp = O + (size_t)(row0 + ai * HALF + m * 16) * ldc + col0;
                float r[8];
#pragma unroll
                for (int n = 0; n < 2; ++n)
#pragma unroll
                    for (int e = 0; e < 4; ++e) r[n * 4 + e] = siluf_(acc[ai][0][m][n][e]) * acc[ai][1][m][n][e];
                u32x4 w; w.x = cvt_pk_bf16(r[0], r[1]); w.y = cvt_pk_bf16(r[2], r[3]); w.z = cvt_pk_bf16(r[4], r[5]); w.w = cvt_pk_bf16(r[6], r[7]);
                *(u32x4*)rowp = w; }
    }
};
struct EpiResid {
    static constexpr bool PERM = false, AFTER_DRAIN = false;
    const float* src0; const float* src1; float* out; const float* gate;
    int dry;
    __device__ __forceinline__ void operator()(const f32x4 (&acc)[2][2][4][2], const Unit& u, int wr, int wc, int fr, int fq) const {
        const int R0 = u.pm * BM; const int grp = R0 < 8192 ? 0 : 1 + ((R0 - 8192) >> 12);
        const float* src = R0 < 8192 ? src0 : src1; const float* gv = gate + grp * 6144;
        const int col0 = u.pn * BM + wc * 32 + 4 * fq;
        f32x4 gt[2][2];
#pragma unroll
        for (int bj = 0; bj < 2; ++bj)
#pragma unroll
            for (int n = 0; n < 2; ++n) gt[bj][n] = *(const f32x4*)(gv + col0 + bj * HALF + n * 16);
#pragma unroll
        for (int ai = 0; ai < 2; ++ai)
#pragma unroll
            for (int mp = 0; mp < 2; ++mp) { f32x4 b[2][2][2];
#pragma unroll
                for (int mm = 0; mm < 2; ++mm) { const size_t off = (size_t)(R0 + ai * HALF + wr * 64 + (2 * mp + mm) * 16 + fr) * 1024 + col0;
#pragma unroll
                    for (int bj = 0; bj < 2; ++bj)
#pragma unroll
                        for (int n = 0; n < 2; ++n) b[mm][bj][n] = *(const f32x4*)(src + off + bj * HALF + n * 16); }
#pragma unroll
                for (int mm = 0; mm < 2; ++mm) { const int m = 2 * mp + mm; const size_t off = (size_t)(R0 + ai * HALF + wr * 64 + m * 16 + fr) * 1024 + col0;
#pragma unroll
                    for (int bj = 0; bj < 2; ++bj)
#pragma unroll
                        for (int n = 0; n < 2; ++n) { if (!dry) *(f32x4*)(out + off + bj * HALF + n * 16) = b[mm][bj][n] + gt[bj][n] * acc[ai][bj][m][n]; } }
                asm volatile("" ::: "memory"); }
    }
};
struct EpiGate {
    static constexpr bool PERM = true, AFTER_DRAIN = false;
    const bf16_t* raw; bf16_t* brg; int MT;
    __device__ __forceinline__ void operator()(const f32x4 (&acc)[2][2][4][2], const Unit& u, int wr, int wc, int fr, int fq) const {
        const int g = u.pn >> 2, pn = u.pn & 3, pm = u.pm - g * MT;
        const int row0 = pm * BM + wr * 64 + fr, col0 = pn * BM + wc * 32 + 8 * fq;
        bf16_t* out = brg + (size_t)g * MT * BM * 1024;
#pragma unroll
        for (int ai = 0; ai < 2; ++ai) { u32x4 gwv[4][2];
#pragma unroll
            for (int m = 0; m < 4; ++m)
#pragma unroll
                for (int bj = 0; bj < 2; ++bj) gwv[m][bj] = *(const u32x4*)(raw + (size_t)(row0 + ai * HALF + m * 16) * 6912 + 3744 + g * 1024 + col0 + bj * HALF);
#pragma unroll
            for (int m = 0; m < 4; ++m) { const int row = row0 + ai * HALF + m * 16;
#pragma unroll
                for (int bj = 0; bj < 2; ++bj) { const int col = col0 + bj * HALF; const u32x4 gw = gwv[m][bj];
                    f32x4 v0 = acc[ai][bj][m][0], v1 = acc[ai][bj][m][1];
                    v0[0] *= sigmoidf_(bf_lo(gw.x)); v0[1] *= sigmoidf_(bf_hi(gw.x)); v0[2] *= sigmoidf_(bf_lo(gw.y)); v0[3] *= sigmoidf_(bf_hi(gw.y));
                    v1[0] *= sigmoidf_(bf_lo(gw.z)); v1[1] *= sigmoidf_(bf_hi(gw.z)); v1[2] *= sigmoidf_(bf_lo(gw.w)); v1[3] *= sigmoidf_(bf_hi(gw.w));
                    u32x4 w; w.x = cvt_pk_bf16(v0[0], v0[1]); w.y = cvt_pk_bf16(v0[2], v0[3]); w.z = cvt_pk_bf16(v1[0], v1[1]); w.w = cvt_pk_bf16(v1[2], v1[3]);
                    *(u32x4*)(out + (size_t)row * 1024 + col) = w; } }
            asm volatile("" ::: "memory"); }
    }
};
struct GateOrder {
    int MT, G, c;
    __device__ bool next(int i, Unit& u) const { const int L = i * G + c; if (L >= 3 * MT * 4) return false; const int g = L / (4 * MT), t = L % (4 * MT); u.pm = g * MT + (t >> 2); u.pn = g * 4 + (t & 3); return true; }
    __device__ __forceinline__ void a_ready(const Unit&) const {}
    __device__ __forceinline__ void done(const Unit&) const {}
};
struct OffsetOrder {
    StaticOrder S;
    __device__ void init(int M, int N, int G, int c, int off) { S.init(M, N, G, (c - off + G) % G); }
    __device__ bool next(int i, Unit& u) const { return S.next(i, u); }
    __device__ __forceinline__ void a_ready(const Unit&) const {}
    __device__ __forceinline__ void done(const Unit&) const {}
};
template <class Epi, class Sched, bool ALIGN_EPI = false, bool SP2 = false>
__device__ __forceinline__ void gemm_phase(PG8_LAS unsigned char* lds, const Gemm g, const Sched& S, const Epi& E) {
    int tid = threadIdx.x; asm volatile("" : "+v"(tid)); const int wid = __builtin_amdgcn_readfirstlane(tid >> 6), lane = tid & 63, wr = wid >> 2, wc = wid & 3, fr = lane & 15, fq = lane >> 4;
    const int K = g.K, nt = K / BK;
    unsigned voffA[2], voffB[2];
#pragma unroll
    for (int i = 0; i < 2; ++i) { int R, C; stage_rc(tid * 16 + i * 8192, R, C); const int Rb = Epi::PERM ? ((R & ~31) + perm32(R & 31)) : R;
        voffA[i] = (unsigned)(R * K + C) * 2u; voffB[i] = (unsigned)(Rb * K + C) * 2u; }
    const size_t kstep = (size_t)(BK * 2);
    const size_t hstep = (size_t)HALF * K * 2;
    const size_t tstep = 2 * hstep;
    const unsigned ldsw = (unsigned)wid * 1024u;
    const int aoff = lds_byte(wr * 64 + fr, fq * 8), boff = lds_byte(wc * 32 + fr, fq * 8);
#define PG8_SA(b, h) (((b) * 2 + (h)) * HTB)
#define PG8_SB(b, h) ((4 + (b) * 2 + (h)) * HTB)
#define PG8_STAGE(bufoff, gbase, voff) do { _Pragma("unroll") for (int _i = 0; _i < 2; ++_i) \
        __builtin_amdgcn_global_load_lds((const unsigned*)((const char*)(gbase) + (voff)[_i]), (PG8_LAS unsigned*)(lds + (bufoff) + ldsw + _i * 8192), 16, 0, 0); } while (0)
#define PG8_LDA(dst, b, h) do { _Pragma("unroll") for (int m = 0; m < 4; ++m) _Pragma("unroll") for (int k = 0; k < 2; ++k) dst[m][k] = *(const PG8_LAS bf16x8*)(lds + PG8_SA(b, h) + aoff + m * 2048 + k * 1024); } while (0)
#define PG8_LDB(dst, b, h) do { _Pragma("unroll") for (int n = 0; n < 2; ++n) _Pragma("unroll") for (int k = 0; k < 2; ++k) dst[n][k] = *(const PG8_LAS bf16x8*)(lds + PG8_SB(b, h) + boff + n * 2048 + k * 1024); } while (0)
#define PG8_MMA(ai, bj, At, Bt) do { __builtin_amdgcn_s_setprio(1); _Pragma("unroll") for (int m = 0; m < 4; ++m) _Pragma("unroll") for (int n = 0; n < 2; ++n) _Pragma("unroll") for (int k = 0; k < 2; ++k) \
        acc[ai][bj][m][n] = __builtin_amdgcn_mfma_f32_16x16x32_bf16(Bt[n][k], At[m][k], acc[ai][bj][m][n], 0, 0, 0); __builtin_amdgcn_s_setprio(0); } while (0)
#define PG8_WAIT_V(n) asm volatile("s_waitcnt vmcnt(" #n ")" ::: "memory")
#define PG8_WAIT_L(n) asm volatile("s_waitcnt lgkmcnt(" #n ")" ::: "memory")
#define PG8_BAR __builtin_amdgcn_s_barrier()
#define PG8_SCHED __builtin_amdgcn_sched_barrier(0)
    Unit cur, nxt; int ui = 0;
    if (!S.next(0, cur)) return;
    f32x4 acc[2][2][4][2];
#pragma unroll
    for (int a = 0; a < 2; ++a)
#pragma unroll
        for (int b = 0; b < 2; ++b)
#pragma unroll
            for (int m = 0; m < 4; ++m)
#pragma unroll
                for (int n = 0; n < 2; ++n) acc[a][b][m][n] = (f32x4){0.f, 0.f, 0.f, 0.f};
    bf16x8 At[4][2], B0[2][2], B1[2][2];
    const char* cA = (const char*)g.A + (size_t)cur.pm * tstep; const char* cB = (const char*)g.Bt + (size_t)cur.pn * tstep;
    S.a_ready(cur);
    if constexpr (SP2) {
        PG8_STAGE(PG8_SB(0, 0), cB, voffB); PG8_STAGE(PG8_SB(0, 1), cB + hstep, voffB); PG8_STAGE(PG8_SA(0, 0), cA, voffA); PG8_STAGE(PG8_SA(0, 1), cA + hstep, voffA);
        if (wr == 1) PG8_BAR;
        PG8_WAIT_V(2); PG8_BAR;
        PG8_STAGE(PG8_SB(1, 0), cB + kstep, voffB); PG8_STAGE(PG8_SA(1, 0), cA + kstep, voffA); PG8_STAGE(PG8_SB(1, 1), cB + hstep + kstep, voffB);
        PG8_WAIT_V(6); PG8_BAR;
    } else {
        PG8_STAGE(PG8_SB(0, 0), cB, voffB); PG8_STAGE(PG8_SA(0, 0), cA, voffA); PG8_STAGE(PG8_SB(0, 1), cB + hstep, voffB); PG8_STAGE(PG8_SA(0, 1), cA + hstep, voffA);
        if (wr == 1) PG8_BAR;
        PG8_WAIT_V(4); PG8_BAR;
        PG8_STAGE(PG8_SB(1, 0), cB + kstep, voffB); PG8_STAGE(PG8_SA(1, 0), cA + kstep, voffA); PG8_STAGE(PG8_SB(1, 1), cB + hstep + kstep, voffB);
        PG8_WAIT_V(6); PG8_BAR;
    }
    for (;;) {
        const bool has_next = S.next(ui + 1, nxt);
        const char* nA = has_next ? (const char*)g.A + (size_t)nxt.pm * tstep : cA; const char* nB = has_next ? (const char*)g.Bt + (size_t)nxt.pn * tstep : cB;
        for (int t = 0; t < nt; t += 2) {
            const bool last = (t == nt - 2);
            const char* a1 = cA + (size_t)(t + 1) * kstep;
            const char* a2 = last ? nA : cA + (size_t)(t + 2) * kstep; const char* b2 = last ? nB : cB + (size_t)(t + 2) * kstep;
            const char* a3 = a2 + kstep; const char* b3 = b2 + kstep;
            if (last && has_next) S.a_ready(nxt);
            if constexpr (SP2) {
            PG8_LDB(B0, 0, 0); PG8_LDB(B1, 0, 1); PG8_SCHED; PG8_LDA(At, 0, 0); PG8_STAGE(PG8_SA(1, 1), a1 + hstep, voffA);
            PG8_WAIT_V(8); PG8_WAIT_L(0); PG8_BAR; PG8_MMA(0, 0, At, B0); PG8_MMA(0, 1, At, B1); PG8_BAR; PG8_SCHED;
            PG8_LDA(At, 0, 1); PG8_STAGE(PG8_SB(0, 0), b2, voffB); PG8_STAGE(PG8_SB(0, 1), b2 + hstep, voffB); PG8_STAGE(PG8_SA(0, 0), a2, voffA);
            PG8_WAIT_V(8); PG8_WAIT_L(0); PG8_BAR; PG8_MMA(1, 0, At, B0); PG8_MMA(1, 1, At, B1); PG8_BAR; PG8_SCHED;
            PG8_LDB(B0, 1, 0); PG8_LDB(B1, 1, 1); PG8_SCHED; PG8_LDA(At, 1, 0); PG8_STAGE(PG8_SA(0, 1), a2 + hstep, voffA);
            PG8_WAIT_V(8); PG8_WAIT_L(0); PG8_BAR; PG8_MMA(0, 0, At, B0); PG8_MMA(0, 1, At, B1); PG8_BAR; PG8_SCHED;
            PG8_LDA(At, 1, 1); PG8_STAGE(PG8_SB(1, 0), b3, voffB); PG8_STAGE(PG8_SB(1, 1), b3 + hstep, voffB); PG8_STAGE(PG8_SA(1, 0), a3, voffA);
            PG8_WAIT_V(8); PG8_WAIT_L(0); PG8_BAR; PG8_MMA(1, 0, At, B0); PG8_MMA(1, 1, At, B1); PG8_BAR; PG8_SCHED;
            } else {
            PG8_LDB(B0, 0, 0); PG8_SCHED; PG8_LDA(At, 0, 0); PG8_STAGE(PG8_SA(1, 1), a1 + hstep, voffA);
            PG8_WAIT_L(8); PG8_BAR; PG8_WAIT_L(0); PG8_MMA(0, 0, At, B0); PG8_BAR; PG8_SCHED;
            PG8_LDB(B1, 0, 1); PG8_STAGE(PG8_SB(0, 0), b2, voffB);
            PG8_BAR; PG8_WAIT_L(0); PG8_MMA(0, 1, At, B1); PG8_BAR;
            PG8_LDA(At, 0, 1); PG8_STAGE(PG8_SA(0, 0), a2, voffA);
            PG8_BAR; PG8_WAIT_L(0); PG8_MMA(1, 0, At, B0); PG8_BAR; PG8_SCHED;
            PG8_STAGE(PG8_SB(0, 1), b2 + hstep, voffB);
            PG8_WAIT_V(6); PG8_BAR; PG8_MMA(1, 1, At, B1); PG8_BAR;
            PG8_LDB(B0, 1, 0); PG8_SCHED; PG8_LDA(At, 1, 0); PG8_STAGE(PG8_SA(0, 1), a2 + hstep, voffA);
            PG8_WAIT_L(8); PG8_BAR; PG8_WAIT_L(0); PG8_MMA(0, 0, At, B0); PG8_BAR; PG8_SCHED;
            PG8_LDB(B1, 1, 1); PG8_STAGE(PG8_SB(1, 0), b3, voffB);
            PG8_BAR; PG8_WAIT_L(0); PG8_MMA(0, 1, At, B1); PG8_BAR;
            PG8_LDA(At, 1, 1); PG8_STAGE(PG8_SA(1, 0), a3, voffA);
            PG8_BAR; PG8_WAIT_L(0); PG8_MMA(1, 0, At, B0); PG8_BAR; PG8_SCHED;
            PG8_STAGE(PG8_SB(1, 1), b3 + hstep, voffB);
            PG8_WAIT_V(6); PG8_BAR; PG8_MMA(1, 1, At, B1); PG8_BAR;
            }
        }
        if constexpr (ALIGN_EPI) { if (wr == 0) PG8_BAR; }
        if constexpr (!Epi::AFTER_DRAIN) { E(acc, cur, wr, wc, fr, fq); S.done(cur); }
        if (!has_next) break;
#pragma unroll
        for (int a = 0; a < 2; ++a)
#pragma unroll
            for (int b = 0; b < 2; ++b)
#pragma unroll
                for (int m = 0; m < 4; ++m)
#pragma unroll
                    for (int n = 0; n < 2; ++n) acc[a][b][m][n] = (f32x4){0.f, 0.f, 0.f, 0.f};
        cur = nxt; cA = nA; cB = nB; ++ui;
        if constexpr (ALIGN_EPI) { if (wr == 1) PG8_BAR; }
    }
    PG8_WAIT_V(0);
    if constexpr (!ALIGN_EPI) { if (wr == 0) PG8_BAR; }
    PG8_BAR;
    if constexpr (Epi::AFTER_DRAIN) { E.fused(acc, cur, wr, wc, fr, fq, lds, wid, lane); S.done(cur); }
#undef PG8_SA
#undef PG8_SB
#undef PG8_STAGE
#undef PG8_LDA
#undef PG8_LDB
#undef PG8_MMA
#undef PG8_WAIT_V
#undef PG8_WAIT_L
#undef PG8_BAR
#undef PG8_SCHED
}
}
#define LAS __attribute__((address_space(3)))
typedef unsigned short bf16_t;
typedef short bf16x8 __attribute__((ext_vector_type(8)));
typedef short s16x4 __attribute__((ext_vector_type(4)));
typedef float f32x4 __attribute__((ext_vector_type(4)));
typedef unsigned u32x4 __attribute__((ext_vector_type(4)));
using pg8::u32x2; using pg8::cvt_pk_bf16; using pg8::bf_lo; using pg8::bf_hi; using pg8::siluf_;
constexpr int NT = 512;
constexpr int DM = 1024, NTOK = 40960, NPR = 8192, NINP = 6912, CHR = 8192, NCOLA = 6144;
constexpr float EPSF = 1e-6f, L2E = 1.4426950408889634f;
constexpr size_t MiB = 1u << 20;
constexpr size_t WS_MOD = 0, WS_LAM = 512 * 1024, WS_ROPE = 1 * MiB, WS_W = 4 * MiB, WL_STRIDE = 37 * MiB;
constexpr size_t WO_IN = 0, WO_UQ = 13 * MiB + 512 * 1024, WO_UKV = 14 * MiB + 256 * 1024, WO_BR = 15 * MiB, WO_OUT = 18 * MiB, WO_FI = 20 * MiB, WO_FO = 31 * MiB;
constexpr size_t WS_ABUF = 78 * MiB, WS_RAW = 158 * MiB, WS_CQN = 266 * MiB, WS_CKVN = 272 * MiB, WS_KPE = 277 * MiB, WS_QMLA = 278 * MiB, WS_KVMLA = 290 * MiB,
                 WS_DKV = 308 * MiB, WS_ODIFF = 326 * MiB, WS_YALL = 358 * MiB, WS_U = 382 * MiB, WS_SIN = 398 * MiB, WS_HID = 158 * MiB, WS_BRG = 382 * MiB  , WS_END = 430 * MiB;
constexpr size_t OUT_YP = 0, OUT_RF = 41943040, OUT_RB = 44040192, OUT_DK = 46137344, OUT_DV = 54525952, OUT_CKV = 62914560, OUT_KPE = 67108864, OUT_TOTAL = 67633152;
constexpr int LDS_BYTES = 147456, MISC_OFF = 131072 + 320;
constexpr size_t WS_CTL = 3 * MiB;

__device__ __forceinline__ float bf2f(bf16_t v) { return __uint_as_float((unsigned)v << 16); }
__device__ __forceinline__ bf16_t f2bf(float f) { unsigned u = __float_as_uint(f); return (bf16_t)((u + 0x7fffu + ((u >> 16) & 1u)) >> 16); }
__device__ __forceinline__ float wave_sum(float v) {
#pragma unroll
    for (int o = 1; o < 64; o <<= 1) v += __shfl_xor(v, o);
    return v;
}
__device__ __forceinline__ s16x4 ds_tr(const LAS unsigned char* p) { return __builtin_bit_cast(s16x4, __builtin_amdgcn_ds_read_tr16_b64_v4i16((LAS s16x4*)p)); }
__device__ __forceinline__ bf16x8 tr2(const LAS unsigned char* p, int rowskip_bytes) { const s16x4 a = ds_tr(p), b = ds_tr(p + rowskip_bytes); return (bf16x8){a[0], a[1], a[2], a[3], b[0], b[1], b[2], b[3]}; }
__device__ __forceinline__ bf16x8 pack8(const f32x4 a, const f32x4 b) { u32x4 w; w.x = cvt_pk_bf16(a[0], a[1]); w.y = cvt_pk_bf16(a[2], a[3]); w.z = cvt_pk_bf16(b[0], b[1]); w.w = cvt_pk_bf16(b[2], b[3]); return __builtin_bit_cast(bf16x8, w); }
#define MFMA16(a, b, c) __builtin_amdgcn_mfma_f32_16x16x32_bf16((a), (b), (c), 0, 0, 0)

struct Params { const float* in[27]; float* out; unsigned char* ws; };

__device__ __forceinline__ void transpose_item(const float* W, int K, int N, bf16_t* WT, int k0, int n0, int dst_row0, LAS float* scr, int lane) {
#pragma unroll
    for (int i = 0; i < 32; ++i) { const int kk = 2 * i + (lane >> 5); scr[kk * 33 + (lane & 31)] = W[(size_t)(k0 + kk) * N + n0 + (lane & 31)]; }
    asm volatile("s_waitcnt lgkmcnt(0)" ::: "memory");
    const int c = lane & 7;
#pragma unroll
    for (int j = 0; j < 4; ++j) { const int n = (lane >> 3) + 8 * j; const LAS float* s = scr + (8 * c) * 33 + n;
        u32x4 o; o.x = cvt_pk_bf16(s[0 * 33], s[1 * 33]); o.y = cvt_pk_bf16(s[2 * 33], s[3 * 33]); o.z = cvt_pk_bf16(s[4 * 33], s[5 * 33]); o.w = cvt_pk_bf16(s[6 * 33], s[7 * 33]);
        *(u32x4*)(WT + (size_t)(dst_row0 + n) * K + k0 + 8 * c) = o; }
    asm volatile("s_waitcnt lgkmcnt(0)" ::: "memory");
}

__device__ __forceinline__ float xmax16(float v) { auto r = __builtin_amdgcn_permlane16_swap(__float_as_uint(v), __float_as_uint(v), false, false); return fmaxf(__uint_as_float(r[0]), __uint_as_float(r[1])); }
__device__ __forceinline__ float xmax32(float v) { auto r = __builtin_amdgcn_permlane32_swap(__float_as_uint(v), __float_as_uint(v), false, false); return fmaxf(__uint_as_float(r[0]), __uint_as_float(r[1])); }
__device__ __forceinline__ float xsum16(float v) { auto r = __builtin_amdgcn_permlane16_swap(__float_as_uint(v), __float_as_uint(v), false, false); return __uint_as_float(r[0]) + __uint_as_float(r[1]); }
__device__ __forceinline__ float xsum32(float v) { auto r = __builtin_amdgcn_permlane32_swap(__float_as_uint(v), __float_as_uint(v), false, false); return __uint_as_float(r[0]) + __uint_as_float(r[1]); }
__device__ __forceinline__ bf16x8 scale8(bf16x8 v, float sc) { const u32x4 w = __builtin_bit_cast(u32x4, v); u32x4 o;
    o.x = cvt_pk_bf16(bf_lo(w.x) * sc, bf_hi(w.x) * sc); o.y = cvt_pk_bf16(bf_lo(w.y) * sc, bf_hi(w.y) * sc); o.z = cvt_pk_bf16(bf_lo(w.z) * sc, bf_hi(w.z) * sc); o.w = cvt_pk_bf16(bf_lo(w.w) * sc, bf_hi(w.w) * sc);
    return __builtin_bit_cast(bf16x8, o); }
#define FA_BAR() do { asm volatile("s_waitcnt lgkmcnt(0)" ::: "memory"); __builtin_amdgcn_s_barrier(); asm volatile("" ::: "memory"); } while (0)
template <int DQK, int DV, bool OUT_BF16, bool TWO = false>
__device__ __forceinline__ void fa_unit(LAS unsigned char* lds, const bf16_t* __restrict__ Q, int qpitch, const bf16_t* __restrict__ K1, int k1pitch,
                                        const bf16_t* __restrict__ K2, int k2pitch, const bf16_t* __restrict__ V, int vpitch, int nkt, float sc, void* Out, int opitch, float lam = 0.f, float osc = 1.f, const float* rcos = nullptr, const float* rsin = nullptr, int pos0 = 0) {
    constexpr int KW = TWO ? 2 * DQK : DQK;
    constexpr int PK = KW + 8, VROW = DV * 2, KB = 64 * PK * 2, VB = 64 * VROW, STG = KB + VB;
    constexpr int KCH = KW / 8, VCH = DV / 8, NK = 64 * KCH, NV = 64 * VCH, KI = (NK + NT - 1) / NT, VI = (NV + NT - 1) / NT, NKS = DQK / 32, NET = DV / 16;
    static_assert(NV % NT == 0 && (NK % NT == 0 || NK - NT * (KI - 1) <= NT) && (NET == 4 || NET == 8), "staging piece counts");
    constexpr int EPP = 32 / (2 * NET);
    int tid = threadIdx.x; asm volatile("" : "+v"(tid)); const int lane = tid & 63, w = tid >> 6, g = lane >> 4, i16 = lane & 15;
    bf16x8 qf[2][NKS];
#pragma unroll
    for (int qt = 0; qt < 2; ++qt)
#pragma unroll
        for (int ks = 0; ks < NKS; ++ks) qf[qt][ks] = scale8(*(const bf16x8*)(Q + (size_t)(TWO ? 16 * w + i16 : 32 * w + 16 * qt + i16) * qpitch + (TWO ? DQK * qt : 0) + 32 * ks + 8 * g), sc);
    if (DQK == 96 && rcos != nullptr) {
#pragma unroll
        for (int qt = 0; qt < 2; ++qt) { const int pos = pos0 + 32 * w + 16 * qt + i16; const float* cp = rcos + (size_t)pos * 16 + 8 * (g & 1); const float* sp = rsin + (size_t)pos * 16 + 8 * (g & 1);
            const f32x4 c0 = *(const f32x4*)cp, c1 = *(const f32x4*)(cp + 4), s0 = *(const f32x4*)sp, s1 = *(const f32x4*)(sp + 4);
            const u32x4 me = __builtin_bit_cast(u32x4, qf[qt][NKS - 1]); u32x4 ot;
#pragma unroll
            for (int q = 0; q < 4; ++q) { const unsigned mw = q == 0 ? me.x : q == 1 ? me.y : q == 2 ? me.z : me.w;
                auto rr = __builtin_amdgcn_permlane32_swap(mw, mw, false, false); const unsigned pw = lane < 32 ? rr[1] : rr[0];
                const float cA = q < 2 ? c0[2 * q] : c1[2 * q - 4], cB = q < 2 ? c0[2 * q + 1] : c1[2 * q - 3], sA = q < 2 ? s0[2 * q] : s1[2 * q - 4], sB = q < 2 ? s0[2 * q + 1] : s1[2 * q - 3];
                const float sg = lane < 32 ? -1.0f : 1.0f;
                const float yA = bf_lo(mw) * cA + sg * bf_lo(pw) * sA, yB = bf_hi(mw) * cB + sg * bf_hi(pw) * sB;
                const unsigned ow = cvt_pk_bf16(yA, yB); if (q == 0) ot.x = ow; else if (q == 1) ot.y = ow; else if (q == 2) ot.z = ow; else ot.w = ow; }
            qf[qt][NKS - 1] = __builtin_bit_cast(bf16x8, ot); }
    }
    f32x4 o[NET][2];
#pragma unroll
    for (int et = 0; et < NET; ++et) { o[et][0] = (f32x4){0.f, 0.f, 0.f, 0.f}; o[et][1] = (f32x4){0.f, 0.f, 0.f, 0.f}; }
    f32x4 lacc[2] = {(f32x4){0.f, 0.f, 0.f, 0.f}, (f32x4){0.f, 0.f, 0.f, 0.f}};
    const bf16x8 ones = (bf16x8){0x3F80, 0x3F80, 0x3F80, 0x3F80, 0x3F80, 0x3F80, 0x3F80, 0x3F80};
    f32x4 negm[2] = {(f32x4){0.f, 0.f, 0.f, 0.f}, (f32x4){0.f, 0.f, 0.f, 0.f}};
    u32x4 kr0[KI], vr0[VI];
#define FA_IDXK(ii) ((tid + NT * (ii)) < NK ? (tid + NT * (ii)) : (tid + NT * (ii)) - NT)
#define FA_GLOADK(kt_, kreg) do { const int ktc_ = (kt_) < nkt ? (kt_) : nkt - 1; \
        _Pragma("unroll") for (int ii = 0; ii < KI; ++ii) { const int idx = FA_IDXK(ii); const int row = idx / KCH, ch = idx % KCH; \
            const bf16_t* src = (TWO || ch < 8) ? K1 + (size_t)(64 * ktc_ + row) * k1pitch + ch * 8 : K2 + (size_t)(64 * ktc_ + row) * k2pitch + (ch - 8) * 8; kreg[ii] = *(const u32x4*)src; } } while (0)
#define FA_GLOADV(vt_, vreg) do { const int vtc_ = (vt_) < nkt ? (vt_) : nkt - 1; \
        _Pragma("unroll") for (int ii = 0; ii < VI; ++ii) { const int idx = tid + NT * ii; const int row = idx / VCH, ch = idx % VCH; \
            vreg[ii] = *(const u32x4*)(V + (size_t)(64 * vtc_ + row) * vpitch + ch * 8); } } while (0)
#define FA_LWRITEK(stg, kreg) do { \
        _Pragma("unroll") for (int ii = 0; ii < KI; ++ii) { const int idx = FA_IDXK(ii); const int row = idx / KCH, ch = idx % KCH; *(LAS u32x4*)(lds + (stg) * STG + row * (PK * 2) + ch * 16) = kreg[ii]; } } while (0)
#define FA_LWRITEV(stg, vreg) do { \
        _Pragma("unroll") for (int ii = 0; ii < VI; ++ii) { const int idx = tid + NT * ii; const int row = idx / VCH, ch = idx % VCH; \
            const int fsw = (DV == 128) ? ((row & 3) | (((row >> 3) & 1) << 2)) : (((row >> 1) & 1) | (((row >> 3) & 1) << 1)); \
            *(LAS u32x4*)(lds + (stg) * STG + KB + row * VROW + ((((ch >> 1) ^ fsw)) << 5) + (ch & 1) * 16) = vreg[ii]; } } while (0)
#define FA_QK(stg) do { const LAS unsigned char* kb_ = lds + (stg) * STG; \
        _Pragma("unroll") for (int ks = 0; ks < NKS; ++ks) \
        _Pragma("unroll") for (int kt = 0; kt < 4; ++kt) { const int krow = 32 * (kt >> 1) + 8 * (i16 >> 2) + 4 * (kt & 1) + (i16 & 3); \
            const bf16x8 a = *(const LAS bf16x8*)(kb_ + krow * (PK * 2) + (32 * ks + 8 * g) * 2); \
            const bf16x8 a1 = TWO ? *(const LAS bf16x8*)(kb_ + krow * (PK * 2) + (DQK + 32 * ks + 8 * g) * 2) : a; \
            s[kt][0] = MFMA16(a, qf[0][ks], ks == 0 ? negm[0] : s[kt][0]); s[kt][1] = MFMA16(a1, qf[1][ks], ks == 0 ? negm[1] : s[kt][1]); } } while (0)
#define FA_MAXCHK(T) do { if (((T) < 2) || (((T) & 3) == 0)) { \
        _Pragma("unroll") for (int qt = 0; qt < 2; ++qt) { float mx = s[0][qt][0]; \
            _Pragma("unroll") for (int kt = 0; kt < 4; ++kt) _Pragma("unroll") for (int r = 0; r < 4; ++r) mx = fmaxf(mx, s[kt][qt][r]); \
            mx = xmax32(xmax16(mx)); const bool grow = ((T) == 0) || (mx > 8.0f); \
            if (__builtin_amdgcn_ballot_w64(grow)) { const float dl = grow ? mx : 0.f, al = __builtin_amdgcn_exp2f(-dl); lacc[qt] = lacc[qt] * al; \
                _Pragma("unroll") for (int kt = 0; kt < 4; ++kt) s[kt][qt] = s[kt][qt] - dl; \
                _Pragma("unroll") for (int et = 0; et < NET; ++et) o[et][qt] = o[et][qt] * al; \
                pf[0][qt] = scale8(pf[0][qt], al); pf[1][qt] = scale8(pf[1][qt], al);        \
                negm[qt] = negm[qt] - dl; } } } } while (0)
#define FA_EXP4(kt, qt) do { s[kt][qt][0] = __builtin_amdgcn_exp2f(s[kt][qt][0]); s[kt][qt][1] = __builtin_amdgcn_exp2f(s[kt][qt][1]); s[kt][qt][2] = __builtin_amdgcn_exp2f(s[kt][qt][2]); s[kt][qt][3] = __builtin_amdgcn_exp2f(s[kt][qt][3]); } while (0)
    const int vq = i16 >> 2; const int vsw = ((DV == 128) ? (vq | ((g & 1) << 2)) : (((vq >> 1) & 1) | ((g & 1) << 1))) << 5;
    f32x4 s[4][2];
    bf16x8 pf[2][2] = {{(bf16x8){0, 0, 0, 0, 0, 0, 0, 0}, (bf16x8){0, 0, 0, 0, 0, 0, 0, 0}}, {(bf16x8){0, 0, 0, 0, 0, 0, 0, 0}, (bf16x8){0, 0, 0, 0, 0, 0, 0, 0}}};
    FA_GLOADK(0, kr0); FA_LWRITEK(1, kr0);
    FA_GLOADK(1, kr0); FA_GLOADV(0, vr0); FA_LWRITEK(0, kr0); FA_LWRITEV(0, vr0);
    FA_GLOADK(2, kr0); FA_GLOADV(1, vr0);
    FA_BAR();
    FA_QK(1);
    FA_MAXCHK(0);
#pragma unroll
    for (int qt = 0; qt < 2; ++qt) {
#pragma unroll
        for (int kt = 0; kt < 4; ++kt) FA_EXP4(kt, qt);
        pf[0][qt] = pack8(s[0][qt], s[1][qt]); pf[1][qt] = pack8(s[2][qt], s[3][qt]); }
    FA_BAR();
#define FA_STEP(t, KR, VR) do { \
        const LAS unsigned char* vb = lds + ((t) & 1) * STG + KB; \
        bf16x8 va[NET]; \
        _Pragma("unroll") for (int et = 0; et < NET; ++et) va[et] = tr2(vb + (8 * g + vq) * VROW + ((et << 5) ^ vsw) + (lane & 3) * 8, 4 * VROW); \
        FA_LWRITEK(((t) + 1) & 1, KR); FA_LWRITEV(((t) + 1) & 1, VR);        \
        FA_GLOADK((t) + 3, KR); FA_GLOADV((t) + 2, VR);                        \
        FA_QK((t) & 1);                                                        \
        const bool more = (t) + 1 < nkt; \
        if (more) FA_MAXCHK((t) + 1); \
        __builtin_amdgcn_sched_barrier(0); \
        _Pragma("unroll") for (int j = 0; j < 2 * NET; ++j) {        \
            const int et = j % NET, sI = j / NET; \
            o[et][0] = MFMA16(va[et], pf[sI][0], o[et][0]); o[et][1] = MFMA16(va[et], pf[sI][1], o[et][1]); \
            if (sI == 0) va[et] = tr2(vb + (32 + 8 * g + vq) * VROW + ((et << 5) ^ vsw) + (lane & 3) * 8, 4 * VROW); \
            _Pragma("unroll") for (int e = 0; e < EPP; ++e) { const int v = j * EPP + e; s[(v & 15) >> 2][v >> 4][v & 3] = __builtin_amdgcn_exp2f(s[(v & 15) >> 2][v >> 4][v & 3]); } \
            if (j == NET - 1) { lacc[0] = MFMA16(ones, pf[0][0], lacc[0]); lacc[1] = MFMA16(ones, pf[0][1], lacc[1]); } \
            if (j == NET) pf[0][0] = pack8(s[0][0], s[1][0]);                \
            if (j == (NET == 8 ? 12 : 6)) pf[0][1] = pack8(s[0][1], s[1][1]); \
            __builtin_amdgcn_sched_barrier(0); } \
        lacc[0] = MFMA16(ones, pf[1][0], lacc[0]); lacc[1] = MFMA16(ones, pf[1][1], lacc[1]); \
        __builtin_amdgcn_sched_barrier(0); \
        pf[1][0] = pack8(s[2][0], s[3][0]); pf[1][1] = pack8(s[2][1], s[3][1]); \
        FA_BAR(); \
    } while (0)
    for (int t = 0; t < nkt; ++t) { FA_STEP(t, kr0, vr0); }
#undef FA_GLOADK
#undef FA_GLOADV
#undef FA_LWRITEK
#undef FA_LWRITEV
#undef FA_QK
#undef FA_STEP
#undef FA_MAXCHK
#undef FA_EXP4
    if (TWO) {
        const float i0 = 1.0f / lacc[0][0], i1 = lam / lacc[1][0]; float ss = 0.f;
#pragma unroll
        for (int et = 0; et < NET; ++et) { o[et][0] = o[et][0] * i0 - o[et][1] * i1; ss += (o[et][0][0] * o[et][0][0] + o[et][0][1] * o[et][0][1]) + (o[et][0][2] * o[et][0][2] + o[et][0][3] * o[et][0][3]); }
        ss = xsum32(xsum16(ss));
        const float scl = rsqrtf(ss * (1.0f / (float)DV) + EPSF) * osc; const size_t ro = (size_t)(16 * w + i16) * opitch;
#pragma unroll
        for (int et = 0; et < NET; ++et) { const f32x4 v = o[et][0] * scl; u32x2 pw; pw.x = cvt_pk_bf16(v[0], v[1]); pw.y = cvt_pk_bf16(v[2], v[3]); *(u32x2*)((bf16_t*)Out + ro + 16 * et + 4 * g) = pw; }
        return;
    }
#pragma unroll
    for (int qt = 0; qt < 2; ++qt) {
        const float lt = lacc[qt][0];
        const float inv = 1.0f / lt; const size_t ro = (size_t)(32 * w + 16 * qt + i16) * opitch;
#pragma unroll
        for (int et = 0; et < NET; ++et) { const f32x4 v = o[et][qt] * inv;
            if (OUT_BF16) { u32x2 pw; pw.x = cvt_pk_bf16(v[0], v[1]); pw.y = cvt_pk_bf16(v[2], v[3]); *(u32x2*)((bf16_t*)Out + ro + 16 * et + 4 * g) = pw; }
            else *(f32x4*)((float*)Out + ro + 16 * et + 4 * g) = v; }
    }
}
constexpr int RPK = 72 * 2, RPV = 136 * 2;
__device__ __forceinline__ void ret_local_unit(LAS unsigned char* lds, const bf16_t* __restrict__ raw, int cg, int h, float lf2, float lb2, float* __restrict__ U) {
    int tid = threadIdx.x; asm volatile("" : "+v"(tid)); const int lane = tid & 63, w = tid >> 6, g = lane >> 4, i16 = lane & 15;
    LAS unsigned char* Kf = lds; LAS unsigned char* Kb = lds + 128 * RPK; LAS unsigned char* Vl = lds + 2 * 128 * RPK;
    const bf16_t* base = raw + (size_t)cg * 128 * NINP;
#pragma unroll
    for (int ii = 0; ii < 2; ++ii) { const int idx = tid + NT * ii, row = idx >> 3, ch = idx & 7;
        const u32x4 kv = *(const u32x4*)(base + (size_t)row * NINP + 256 + h * 64 + ch * 8);
        const float zf = __builtin_amdgcn_exp2f((float)(127 - row) * lf2), zb = __builtin_amdgcn_exp2f((float)row * lb2);
        u32x4 a, b;
        a.x = cvt_pk_bf16(bf_lo(kv.x) * zf, bf_hi(kv.x) * zf); a.y = cvt_pk_bf16(bf_lo(kv.y) * zf, bf_hi(kv.y) * zf); a.z = cvt_pk_bf16(bf_lo(kv.z) * zf, bf_hi(kv.z) * zf); a.w = cvt_pk_bf16(bf_lo(kv.w) * zf, bf_hi(kv.w) * zf);
        b.x = cvt_pk_bf16(bf_lo(kv.x) * zb, bf_hi(kv.x) * zb); b.y = cvt_pk_bf16(bf_lo(kv.y) * zb, bf_hi(kv.y) * zb); b.z = cvt_pk_bf16(bf_lo(kv.z) * zb, bf_hi(kv.z) * zb); b.w = cvt_pk_bf16(bf_lo(kv.w) * zb, bf_hi(kv.w) * zb);
        *(LAS u32x4*)(Kf + row * RPK + ch * 16) = a; *(LAS u32x4*)(Kb + row * RPK + ch * 16) = b; }
#pragma unroll
    for (int ii = 0; ii < 4; ++ii) { const int idx = tid + NT * ii, row = idx >> 4, ch = idx & 15;
        *(LAS u32x4*)(Vl + row * RPV + ch * 16) = *(const u32x4*)(base + (size_t)row * NINP + 512 + h * 128 + ch * 8); }
    __syncthreads();
    f32x4 af[4], ab[4];
#pragma unroll
    for (int dt = 0; dt < 4; ++dt) { af[dt] = (f32x4){0.f, 0.f, 0.f, 0.f}; ab[dt] = (f32x4){0.f, 0.f, 0.f, 0.f}; }
#pragma unroll
    for (int s = 0; s < 4; ++s) { const int r0 = 32 * s + 8 * g + (i16 >> 2), c4 = 4 * (lane & 3);
        const bf16x8 a = tr2(Vl + r0 * RPV + (16 * w + c4) * 2, 4 * RPV);
        bf16x8 bfr[4], bbr[4];
#pragma unroll
        for (int dt = 0; dt < 4; ++dt) { bfr[dt] = tr2(Kf + r0 * RPK + (16 * dt + c4) * 2, 4 * RPK); bbr[dt] = tr2(Kb + r0 * RPK + (16 * dt + c4) * 2, 4 * RPK); }
#pragma unroll
        for (int dt = 0; dt < 4; ++dt) { af[dt] = MFMA16(a, bfr[dt], af[dt]); ab[dt] = MFMA16(a, bbr[dt], ab[dt]); } }
    float* uf = U + ((size_t)(0 * 64 + cg) * 4 + h) * 8192; float* ub = U + ((size_t)(1 * 64 + cg) * 4 + h) * 8192;
#pragma unroll
    for (int dt = 0; dt < 4; ++dt) { const int off = (16 * dt + i16) * 128 + 16 * w + 4 * g; *(f32x4*)(uf + off) = af[dt]; *(f32x4*)(ub + off) = ab[dt]; }
    __syncthreads();
}
__device__ __forceinline__ void ret_out_unit(LAS unsigned char* lds, const bf16_t* __restrict__ raw, int cg, int h, float lf2, float lb2, const float* __restrict__ SIN, bf16_t* __restrict__ yret) {
    int tid = threadIdx.x; asm volatile("" : "+v"(tid)); const int lane = tid & 63, w = tid >> 6, g = lane >> 4, i16 = lane & 15;
    LAS unsigned char* Ql = lds; LAS unsigned char* Kl = lds + 128 * RPK; LAS unsigned char* Vl = lds + 2 * 128 * RPK; LAS unsigned char* Sfl = Vl + 128 * RPV; LAS unsigned char* Sbl = Sfl + 64 * RPV;
    const bf16_t* base = raw + (size_t)cg * 128 * NINP;
#pragma unroll
    for (int ii = 0; ii < 2; ++ii) { const int idx = tid + NT * ii, row = idx >> 3, ch = idx & 7;
        *(LAS u32x4*)(Ql + row * RPK + ch * 16) = *(const u32x4*)(base + (size_t)row * NINP + h * 64 + ch * 8);
        *(LAS u32x4*)(Kl + row * RPK + ch * 16) = *(const u32x4*)(base + (size_t)row * NINP + 256 + h * 64 + ch * 8); }
#pragma unroll
    for (int ii = 0; ii < 4; ++ii) { const int idx = tid + NT * ii, row = idx >> 4, ch = idx & 15;
        *(LAS u32x4*)(Vl + row * RPV + ch * 16) = *(const u32x4*)(base + (size_t)row * NINP + 512 + h * 128 + ch * 8); }
    const float* sf = SIN + ((size_t)(0 * 64 + cg) * 4 + h) * 8192; const float* sb = SIN + ((size_t)(1 * 64 + cg) * 4 + h) * 8192;
#pragma unroll
    for (int ii = 0; ii < 4; ++ii) { const int i4 = (tid + NT * ii) * 4, d = i4 >> 7, e = i4 & 127;
        const f32x4 a = *(const f32x4*)(sf + i4), b = *(const f32x4*)(sb + i4);
        u32x2 pa, pb; pa.x = cvt_pk_bf16(a[0], a[1]); pa.y = cvt_pk_bf16(a[2], a[3]); pb.x = cvt_pk_bf16(b[0], b[1]); pb.y = cvt_pk_bf16(b[2], b[3]);
        *(LAS u32x2*)(Sfl + d * RPV + e * 2) = pa; *(LAS u32x2*)(Sbl + d * RPV + e * 2) = pb; }
    __syncthreads();
    const int il = 16 * w + i16;
    bf16x8 qf[2];
#pragma unroll
    for (int ks = 0; ks < 2; ++ks) qf[ks] = *(const LAS bf16x8*)(Ql + il * RPK + (32 * ks + 8 * g) * 2);
    f32x4 o[8];
#pragma unroll
    for (int et = 0; et < 8; ++et) o[et] = (f32x4){0.f, 0.f, 0.f, 0.f};
    const int c4 = 4 * (lane & 3);
#pragma unroll
    for (int jb = 0; jb < 2; ++jb) {
        f32x4 st[4];
#pragma unroll
        for (int kt = 0; kt < 4; ++kt) st[kt] = (f32x4){0.f, 0.f, 0.f, 0.f};
#pragma unroll
        for (int ks = 0; ks < 2; ++ks)
#pragma unroll
            for (int kt = 0; kt < 4; ++kt) { const int krow = 64 * jb + 32 * (kt >> 1) + 8 * (i16 >> 2) + 4 * (kt & 1) + (i16 & 3);
                st[kt] = MFMA16(*(const LAS bf16x8*)(Kl + krow * RPK + (32 * ks + 8 * g) * 2), qf[ks], st[kt]); }
#pragma unroll
        for (int kt = 0; kt < 4; ++kt)
#pragma unroll
            for (int r = 0; r < 4; ++r) { const int j = 64 * jb + 32 * (kt >> 1) + 8 * g + 4 * (kt & 1) + r; const int df = il - j;
                const float wgt = df >= 0 ? __builtin_amdgcn_exp2f((float)df * lf2) : __builtin_amdgcn_exp2f((float)(-df) * lb2); st[kt][r] *= wgt; }
        const bf16x8 p0 = pack8(st[0], st[1]), p1 = pack8(st[2], st[3]);
        bf16x8 vfa[8], vfb[8];
#pragma unroll
        for (int et = 0; et < 8; ++et) { vfa[et] = tr2(Vl + (64 * jb + 8 * g + (i16 >> 2)) * RPV + (16 * et + c4) * 2, 4 * RPV); vfb[et] = tr2(Vl + (64 * jb + 32 + 8 * g + (i16 >> 2)) * RPV + (16 * et + c4) * 2, 4 * RPV); }
#pragma unroll
        for (int et = 0; et < 8; ++et) { o[et] = MFMA16(vfa[et], p0, o[et]); o[et] = MFMA16(vfb[et], p1, o[et]); }
    }
    const float xif = __builtin_amdgcn_exp2f((float)(il + 1) * lf2), xib = __builtin_amdgcn_exp2f((float)(128 - il) * lb2);
#pragma unroll
    for (int e2 = 0; e2 < 4; ++e2) {
        bf16x8 sfr[2][2], sbr[2][2];
#pragma unroll
        for (int q = 0; q < 2; ++q)
#pragma unroll
            for (int ks = 0; ks < 2; ++ks) { const int r0 = 32 * ks + 8 * g + (i16 >> 2); const int et = 2 * e2 + q;
                sfr[q][ks] = tr2(Sfl + r0 * RPV + (16 * et + c4) * 2, 4 * RPV); sbr[q][ks] = tr2(Sbl + r0 * RPV + (16 * et + c4) * 2, 4 * RPV); }
#pragma unroll
        for (int q = 0; q < 2; ++q) { const int et = 2 * e2 + q;
            f32x4 tf = (f32x4){0.f, 0.f, 0.f, 0.f}, tb = (f32x4){0.f, 0.f, 0.f, 0.f};
            tf = MFMA16(sfr[q][0], qf[0], tf); tb = MFMA16(sbr[q][0], qf[0], tb); tf = MFMA16(sfr[q][1], qf[1], tf); tb = MFMA16(sbr[q][1], qf[1], tb);
            o[et] = o[et] + tf * xif + tb * xib; }
    }
    float sm = 0.f;
#pragma unroll
    for (int et = 0; et < 8; ++et) sm += (o[et][0] + o[et][1]) + (o[et][2] + o[et][3]);
    sm += __shfl_xor(sm, 16); sm += __shfl_xor(sm, 32);
    const float mean = sm * (1.0f / 128.0f); float vs = 0.f;
#pragma unroll
    for (int et = 0; et < 8; ++et) { const f32x4 d = o[et] - mean; vs += (d[0] * d[0] + d[1] * d[1]) + (d[2] * d[2] + d[3] * d[3]); }
    vs += __shfl_xor(vs, 16); vs += __shfl_xor(vs, 32);
    const float rstd = rsqrtf(vs * (1.0f / 128.0f) + EPSF);
    const size_t row = (size_t)cg * 128 + il;
    u32x2 rgv[8];
#pragma unroll
    for (int et = 0; et < 8; ++et) rgv[et] = *(const u32x2*)(raw + row * NINP + 1024 + h * 128 + 16 * et + 4 * g);
#pragma unroll
    for (int et = 0; et < 8; ++et) { const int e = 16 * et + 4 * g;
        const u32x2 rg = rgv[et];
        const f32x4 y = (o[et] - mean) * rstd;
        u32x2 pw; pw.x = cvt_pk_bf16(siluf_(bf_lo(rg.x)) * y[0], siluf_(bf_hi(rg.x)) * y[1]); pw.y = cvt_pk_bf16(siluf_(bf_lo(rg.y)) * y[2], siluf_(bf_hi(rg.y)) * y[3]);
        *(u32x2*)(yret + row * 512 + h * 128 + e) = pw; }
    __syncthreads();
}
#define XB_TMO      128
#define XB_XCNT(j)  (256  + 64 * (j))
#define XB_XSUB(j)  (1280 + 64 * (j))
#define XB_XGEN(j)  (2304 + 64 * (j))
#define XB_TOP      3328
#define XB_TOPGEN   3392
#define XCD_BAR_WORDS 3456
#define XB_SPIN_CAP (1u << 18)

__device__ __forceinline__ unsigned xb_ld(unsigned* p)              { return __hip_atomic_load(p, __ATOMIC_RELAXED, __HIP_MEMORY_SCOPE_AGENT); }
__device__ __forceinline__ unsigned xb_add(unsigned* p, unsigned v) { return __hip_atomic_fetch_add(p, v, __ATOMIC_RELAXED, __HIP_MEMORY_SCOPE_AGENT); }
__device__ __forceinline__ unsigned xb_xcc_id() { return (unsigned)__builtin_amdgcn_s_getreg((3 << 11) | 20) & 0xFu; }
#define XB_SPIN(cond, bar) do { unsigned _sp = 0; while (cond) { __builtin_amdgcn_s_sleep(1); \
    if ((++_sp & 255u) == 0u) { if (xb_ld(&(bar)[XB_TMO])) break; if (_sp > XB_SPIN_CAP) { atomicAdd(&(bar)[XB_TMO], 1u); break; } } } } while (0)

struct XcdBarrier {
    unsigned* bar; unsigned x;
    volatile LAS unsigned* st;
};

__device__ __forceinline__ XcdBarrier xcd_barrier_post(unsigned* bar, volatile LAS unsigned* st) {
    XcdBarrier b; b.bar = bar; b.x = xb_xcc_id(); b.st = st;
    if (threadIdx.x == 0) (void)xb_add(&bar[XB_XCNT(b.x)], 1u);
    return b;
}
__device__ __forceinline__ void xcd_barrier_complete(unsigned* bar, unsigned x, unsigned& nloc, unsigned& nx) {
    const unsigned G = gridDim.x * gridDim.y * gridDim.z;
    unsigned sum, cnt, mine, sp = 0u;
    for (;;) {
        sum = 0u; cnt = 0u; mine = 0u;
#pragma unroll
        for (unsigned j = 0; j < 16; ++j) { const unsigned c = xb_ld(&bar[XB_XCNT(j)]); sum += c; cnt += (c > 0u) ? 1u : 0u; mine = (j == x) ? c : mine; }
        if (sum == G) break;
        __builtin_amdgcn_s_sleep(1);
        if ((++sp & 255u) == 0u) { if (xb_ld(&bar[XB_TMO])) break; if (sp > XB_SPIN_CAP) { atomicAdd(&bar[XB_TMO], 1u); break; } }
    }
    nloc = mine > 0u ? mine : 1u; nx = cnt > 0u ? cnt : 1u;
}

__device__ __forceinline__ void xcd_barrier(const XcdBarrier& b) {
    asm volatile("s_waitcnt vmcnt(0)" ::: "memory");
    __syncthreads();
    if (threadIdx.x == 0) {
        unsigned* bar = b.bar;
        __builtin_amdgcn_s_waitcnt(0);
        unsigned nloc = b.st[0], nx = b.st[1];
        if (nloc == 0u) { xcd_barrier_complete(bar, b.x, nloc, nx); b.st[0] = nloc; b.st[1] = nx; }
        const unsigned old = xb_add(&bar[XB_XSUB(b.x)], 1u);
        const unsigned gen = old / nloc;
        if (old + 1u == (gen + 1u) * nloc) {
            __builtin_amdgcn_fence(__ATOMIC_RELEASE, "agent");
            asm volatile("s_waitcnt vmcnt(0)" ::: "memory");
            const unsigned og = xb_add(&bar[XB_TOP], 1u);
            const unsigned tg = og / nx;
            if (og + 1u == (tg + 1u) * nx) xb_add(&bar[XB_TOPGEN], 1u);
            else XB_SPIN(xb_ld(&bar[XB_TOPGEN]) == tg, bar);
            __builtin_amdgcn_fence(__ATOMIC_ACQUIRE, "agent");
            xb_add(&bar[XB_XGEN(b.x)], 1u);
            asm volatile("s_waitcnt vmcnt(0)" ::: "memory");
        } else {
            XB_SPIN(xb_ld(&bar[XB_XGEN(b.x)]) == gen, bar);
            __builtin_amdgcn_fence(__ATOMIC_ACQUIRE, "agent");
            asm volatile("s_waitcnt vmcnt(0)" ::: "memory");
        }
    }
    __syncthreads();
}

typedef const __attribute__((address_space(4))) Params KParams;
#define ENV \
    int phv = ph; asm volatile("" : "+s"(phv)); \
    KParams* pk = (KParams*)__builtin_amdgcn_kernarg_segment_ptr(); asm volatile("" : "+s"(pk)); \
    int tid = threadIdx.x; asm volatile("" : "+v"(tid)); \
    const int lane = tid & 63, wave = __builtin_amdgcn_readfirstlane(tid >> 6); \
    int G = gridDim.x, bx = blockIdx.x; asm volatile("" : "+s"(G), "+s"(bx)); \
    const int vcu = (G % 8 == 0) ? (bx % 8) * (G / 8) + bx / 8 : bx; \
    const int gw = vcu * 8 + wave, NGW = G * 8; \
    unsigned char* ws = pk->ws; \
    float* modv = (float*)(ws + WS_MOD); float* lamv = (float*)(ws + WS_LAM); \
    float* cos64 = (float*)(ws + WS_ROPE); float* sin64 = cos64 + 4096 * 32; float* cos32 = sin64 + 4096 * 32; float* sin32 = cos32 + 4096 * 16; \
    bf16_t* ABUF = (bf16_t*)(ws + WS_ABUF); bf16_t* RAW = (bf16_t*)(ws + WS_RAW); bf16_t* CQN = (bf16_t*)(ws + WS_CQN); bf16_t* CKVN = (bf16_t*)(ws + WS_CKVN); \
    bf16_t* KPE = (bf16_t*)(ws + WS_KPE); bf16_t* QMLA = (bf16_t*)(ws + WS_QMLA); bf16_t* KVMLA = (bf16_t*)(ws + WS_KVMLA); bf16_t* DKV = (bf16_t*)(ws + WS_DKV); \
    float* ODIFF = (float*)(ws + WS_ODIFF); bf16_t* YALL = (bf16_t*)(ws + WS_YALL); float* UST = (float*)(ws + WS_U); float* SIN = (float*)(ws + WS_SIN); bf16_t* HID = (bf16_t*)(ws + WS_HID); bf16_t* BRG = (bf16_t*)(ws + WS_BRG); (void)BRG; \
    float* xres = pk->out + OUT_YP; \
    (void)lane; (void)gw; (void)NGW; (void)modv; (void)lamv; (void)cos64; (void)sin64; (void)cos32; (void)sin32; (void)ABUF; (void)RAW; (void)CQN; (void)CKVN; (void)KPE; (void)QMLA; (void)KVMLA; (void)DKV; \
    (void)ODIFF; (void)YALL; (void)UST; (void)SIN; (void)HID; (void)xres; (void)vcu;
#define LAYER_ENV \
    const int q_ = phv - 1, l = q_ / 36, rr_ = q_ % 36; (void)rr_; \
    unsigned char* wl = ws + WS_W + (size_t)l * WL_STRIDE; const float* modl = modv + l * 9 * 6144; \
    const float* xs0 = l == 0 ? pk->in[0] : xres; const float* xs1 = l == 0 ? pk->in[1] - (size_t)NPR * DM : xres; (void)wl; (void)modl; (void)xs0; (void)xs1;
#define CHUNK_ENV \
    const int ck = rr_ == 31 ? 4 : (rr_ - 1) / 6; const bool prompt = ck == 0; \
    const int row0 = ck * CHR, b0 = prompt ? 0 : 2 * (ck - 1), SEQL = prompt ? 256 : 4096, LK = prompt ? 256 : 4608, PAST = prompt ? 0 : 512, KVR = prompt ? 8192 : 9216, NCH = SEQL / 128, NQB = SEQL / 256; \
    (void)row0; (void)b0; (void)SEQL; (void)LK; (void)PAST; (void)KVR; (void)NCH; (void)NQB;
#define LGF(h) (lamv[8 + l * 8 + (h)])
#define LGB(h) (lamv[8 + l * 8 + 4 + (h)])

#define SUM3(a_, b_, c_) cvt_pk_bf16(bf_lo(a_) + bf_lo(b_) + bf_lo(c_), bf_hi(a_) + bf_hi(b_) + bf_hi(c_))
#define SUM_ROWS(w0_, wn_, dstrow0_) do { \
        for (int r = (w0_); r < CHR; r += (wn_)) { const size_t off = (size_t)r * 1024 + 8 * lane; \
            const u32x4 a0 = *(const u32x4*)(BRG + off), b0 = *(const u32x4*)(BRG + (size_t)CHR * 1024 + off), c0 = *(const u32x4*)(BRG + (size_t)2 * CHR * 1024 + off); \
            const u32x4 a1 = *(const u32x4*)(BRG + off + 512), b1 = *(const u32x4*)(BRG + (size_t)CHR * 1024 + off + 512), c1 = *(const u32x4*)(BRG + (size_t)2 * CHR * 1024 + off + 512); \
            u32x4 w0, w1; w0.x = SUM3(a0.x, b0.x, c0.x); w0.y = SUM3(a0.y, b0.y, c0.y); w0.z = SUM3(a0.z, b0.z, c0.z); w0.w = SUM3(a0.w, b0.w, c0.w); \
            w1.x = SUM3(a1.x, b1.x, c1.x); w1.y = SUM3(a1.y, b1.y, c1.y); w1.z = SUM3(a1.z, b1.z, c1.z); w1.w = SUM3(a1.w, b1.w, c1.w); \
            *(u32x4*)(ABUF + (size_t)(dstrow0_) * DM + off) = w0; *(u32x4*)(ABUF + (size_t)(dstrow0_) * DM + off + 512) = w1; } } while (0)
__global__ void __launch_bounds__(NT, 2) fwd_megakernel(Params p_unused) {
    extern __shared__ __attribute__((aligned(16))) unsigned char lds_raw[];
    LAS unsigned char* lds = (LAS unsigned char*)lds_raw;
    cg::grid_group grid = cg::this_grid();
    if (threadIdx.x < 32) ((volatile LAS unsigned*)(lds + MISC_OFF))[threadIdx.x] = 0u;
    __syncthreads();
    { KParams* pk0 = (KParams*)__builtin_amdgcn_kernarg_segment_ptr(); (void)xcd_barrier_post((unsigned*)(pk0->ws + WS_CTL), (volatile LAS unsigned*)(lds + MISC_OFF) + 8); }
    for (int ph = 0; ph < 74; ++ph) {
        int kind;
        if (ph == 0) kind = 0; else if (ph == 73) kind = 13; else { const int r = (ph - 1) % 36; const int ci = (r - 1) % 6; kind = r == 0 ? 1 : r <= 30 ? (ci == 5 ? 8 : 2 + ci) : r == 31 ? 14 : 9 + (r - 32); }
        if (kind == 0) { ENV
        for (int prb_ = 0; prb_ < PROBE_EW_REPS; ++prb_) {
        LAS float* sl = (LAS float*)lds; LAS float* red = (LAS float*)(lds + 40960);
        for (int blk = bx; blk < 192; blk += G) {
            const int l = blk / 96, n0 = (blk % 96) * 64;
            for (int i = tid; i < 9 * 1024; i += NT) { const int r = i >> 10, k = i & 1023; const float cv = r == 0 ? pk->in[9][k] : pk->in[8][(r - 1) * 1024 + k]; sl[i] = siluf_(cv); }
            __syncthreads();
            const int col = n0 + (tid & 63), ks = tid >> 6;
            float acc[9];
#pragma unroll
            for (int r = 0; r < 9; ++r) acc[r] = 0.f;
            const float* wa = pk->in[12] + (size_t)l * 1024 * 6144 + col;
#pragma unroll 16
            for (int k = ks * 128; k < ks * 128 + 128; ++k) { const float wv = wa[(size_t)k * 6144];
#pragma unroll
                for (int r = 0; r < 9; ++r) acc[r] += sl[r * 1024 + k] * wv; }
#pragma unroll
            for (int r = 0; r < 9; ++r) red[(ks * 9 + r) * 64 + (tid & 63)] = acc[r];
            __syncthreads();
            for (int i = tid; i < 9 * 64; i += NT) { const int r = i >> 6, cc = i & 63; float s = pk->in[13][l * 6144 + n0 + cc];
#pragma unroll
                for (int q = 0; q < 8; ++q) s += red[(q * 9 + r) * 64 + cc];
                modv[(l * 9 + r) * 6144 + n0 + cc] = s; }
            __syncthreads();
        }
        if (bx == 0 && tid < 2) { const int l = tid; const float* dl = pk->in[17] + l * 256; float s1 = 0.f, s2 = 0.f;
            for (int i = 0; i < 64; ++i) { s1 += dl[i] * dl[64 + i]; s2 += dl[128 + i] * dl[192 + i]; }
            const float li = l == 0 ? 0.2f : 0.8f - 0.6f * 0.74081822068171786f;
            lamv[l] = __expf(s1) - __expf(s2) + li; lamv[2 + l] = li;
            float df[4], db[4];
            for (int h = 0; h < 4; ++h) { df[h] = pk->in[15][l * 4 + h]; db[h] = pk->in[16][l * 4 + h]; }
            for (int h = 0; h < 4; ++h) { lamv[8 + l * 8 + h] = -__logf(1.0f + __expf(-df[h])) * L2E; lamv[8 + l * 8 + 4 + h] = -__logf(1.0f + __expf(-db[h])) * L2E; } }
        for (int i = bx * NT + tid; i < 4096 * 48; i += G * NT) {
            int pos, dd, nf; float* cd; float* sd;
            if (i < 4096 * 32) { pos = i >> 5; dd = i & 31; nf = 16; cd = cos64 + i; sd = sin64 + i; } else { const int j = i - 4096 * 32; pos = j >> 4; dd = j & 15; nf = 8; cd = cos32 + j; sd = sin32 + j; }
            const int f = dd % nf; const float basev = dd < nf ? (float)(pos >> 6) : (float)(pos & 63);
            const float inv = __builtin_amdgcn_exp2f(-(float)f / (float)nf * 13.287712379549449f);
            const float ang = basev * inv; const float kq = rintf(ang * 0.15915494309189535f);
            float r = fmaf(-kq, 6.28125f, ang); r = fmaf(-kq, 1.9353071795864769e-3f, r);
            *cd = __cosf(r); *sd = __sinf(r);
        }
        __syncthreads();
        LAS float* scr = (LAS float*)(lds + wave * 16384);
        constexpr int I_IN = 16 * 213, I_UQ = 6 * 24, I_UKV = 4 * 32, I_BR = 8 * 32, I_OUT = 16 * 32, I_FI = 16 * 176, I_FO = 44 * 32;
        constexpr int I_L = I_IN + I_UQ + I_UKV + 3 * I_BR + I_OUT + I_FI + I_FO;
        for (int it = gw; it < 2 * I_L; it += NGW) {
            const int l = it / I_L; int r = it % I_L; unsigned char* wl = ws + WS_W + (size_t)l * WL_STRIDE;
            if (r < I_IN) { const int kb = r / 213, nb = r % 213; transpose_item(pk->in[14] + (size_t)l * 1024 * 6816, 1024, 6816, (bf16_t*)(wl + WO_IN), 64 * kb, 32 * nb, 32 * nb, scr, lane); continue; } r -= I_IN;
            if (r < I_UQ) { const int kb = r / 24, nb = r % 24; transpose_item(pk->in[20] + (size_t)l * 384 * 768, 384, 768, (bf16_t*)(wl + WO_UQ), 64 * kb, 32 * nb, 32 * nb, scr, lane); continue; } r -= I_UQ;
            if (r < I_UKV) { const int kb = r / 32, nb = r % 32; transpose_item(pk->in[21] + (size_t)l * 256 * 1024, 256, 1024, (bf16_t*)(wl + WO_UKV), 64 * kb, 32 * nb, 32 * nb, scr, lane); continue; } r -= I_UKV;
            if (r < 3 * I_BR) { const int gg = r / I_BR, rr = r % I_BR, kb = rr / 32, nb = rr % 32;
                transpose_item(pk->in[22] + ((size_t)l * 3 + gg) * 512 * 1024, 512, 1024, (bf16_t*)(wl + WO_BR), 64 * kb, 32 * nb, gg * 1024 + 32 * nb, scr, lane); continue; } r -= 3 * I_BR;
            if (r < I_OUT) { const int kb = r / 32, nb = r % 32; transpose_item(pk->in[23] + (size_t)l * 1024 * 1024, 1024, 1024, (bf16_t*)(wl + WO_OUT), 64 * kb, 32 * nb, 32 * nb, scr, lane); continue; } r -= I_OUT;
            if (r < I_FI) { const int kb = r / 176, nb = r % 176; const int n0 = 32 * nb; const int dst = n0 < 2816 ? 256 * (n0 / 128) + (n0 % 128) : 256 * ((n0 - 2816) / 128) + 128 + ((n0 - 2816) % 128);
                transpose_item(pk->in[24] + (size_t)l * 1024 * 5632, 1024, 5632, (bf16_t*)(wl + WO_FI), 64 * kb, n0, dst, scr, lane); continue; } r -= I_FI;
            { const int kb = r / 32, nb = r % 32; transpose_item(pk->in[25] + (size_t)l * 2816 * 1024, 2816, 1024, (bf16_t*)(wl + WO_FO), 64 * kb, 32 * nb, 32 * nb, scr, lane); }
        }
        __syncthreads(); }
        }
        else if (kind == 1) { ENV LAYER_ENV
        for (int prb_ = 0; prb_ < PROBE_EW_REPS; ++prb_)
        for (int m = gw; m < NTOK; m += NGW) {
            const int grp = m < NPR ? 0 : 1 + ((m - NPR) >> 12); const float* xr = (m < NPR ? xs0 : xs1) + (size_t)m * DM; const float* md = modl + grp * 6144; const float* gn = pk->in[10] + l * DM;
            f32x4 v[4]; float ss = 0.f;
#pragma unroll
            for (int j = 0; j < 4; ++j) { v[j] = *(const f32x4*)(xr + 4 * lane + 256 * j); ss += (v[j][0] * v[j][0] + v[j][1] * v[j][1]) + (v[j][2] * v[j][2] + v[j][3] * v[j][3]); }
            const float rstd = rsqrtf(wave_sum(ss) * (1.0f / DM) + EPSF);
#pragma unroll
            for (int j = 0; j < 4; ++j) { const int c = 4 * lane + 256 * j; const f32x4 gg = *(const f32x4*)(gn + c), sh = *(const f32x4*)(md + c), scv = *(const f32x4*)(md + 1024 + c);
                const f32x4 y = v[j] * rstd * gg * (scv + 1.0f) + sh; u32x2 pw; pw.x = cvt_pk_bf16(y[0], y[1]); pw.y = cvt_pk_bf16(y[2], y[3]);
                *(u32x2*)(ABUF + (size_t)m * DM + c) = pw; }
        } }
        else if (kind == 2) { ENV LAYER_ENV CHUNK_ENV
            for (int prg_ = 0; prg_ < PROBE_G1_REPS; ++prg_)
            { pg8::Gemm g{ABUF + (size_t)row0 * DM, (const bf16_t*)(wl + WO_IN), CHR, NCOLA, DM}; pg8::StaticOrder S; S.init(CHR, NCOLA, G, bx); pg8::EpiRaw E{RAW, NINP};

          pg8::gemm_phase<pg8::EpiRaw, pg8::StaticOrder, true, true>(lds, g, S, E);
 }
        }
        else if (kind == 3) { ENV LAYER_ENV CHUNK_ENV
            { pg8::Gemm g{ABUF + (size_t)row0 * DM, (const bf16_t*)(wl + WO_IN) + (size_t)NCOLA * DM, CHR, NINP - NCOLA, DM}; pg8::StaticOrder S; S.init(CHR, NINP - NCOLA, G, bx); pg8::EpiRaw E{RAW + NCOLA, NINP};
              pg8::gemm_phase<pg8::EpiRaw, pg8::StaticOrder, true, true>(lds, g, S, E); }
            const int nun = (CHR / 256) * ((NINP - NCOLA) / 256); const bool split = nun < G;
            const int pw0 = split ? (bx - nun) * 8 + wave : gw, pwn = split ? (G - nun) * 8 : NGW;
            if (!split || bx >= nun) {
            for (int r = pw0; r < CHR + (prompt ? 0 : 1024); r += pwn) {
                if (r < CHR) {
                    bf16_t* rp = RAW + (size_t)r * NINP; const int bb = r / SEQL, s = r % SEQL; const size_t kvrow = (size_t)bb * LK + PAST + s; const size_t orow = ((size_t)bb * 2 + l) * 256 + s;
                    const int dd = lane & 31, hq = lane >> 5;
                    float ra[8], rb[8], ka[4], kb[4], cqv[6], ckvv[4];
#pragma unroll
                    for (int i = 0; i < 8; ++i) { const int head = 2 * i + hq; const int cb = head < 8 ? head * 64 : 1536 + (head - 8) * 64; ra[i] = bf2f(rp[cb + dd]); rb[i] = bf2f(rp[cb + dd + 32]); }
#pragma unroll
                    for (int i = 0; i < 4; ++i) { const int cb = 2048 + (2 * i + hq) * 64; ka[i] = bf2f(rp[cb + dd]); kb[i] = bf2f(rp[cb + dd + 32]); }
                    const u32x4 dv = *(const u32x4*)(rp + 2560 + 8 * lane);
#pragma unroll
                    for (int i = 0; i < 6; ++i) cqv[i] = bf2f(rp[3072 + lane + 64 * i]);
#pragma unroll
                    for (int i = 0; i < 4; ++i) ckvv[i] = bf2f(rp[3456 + lane + 64 * i]);
                    float p1 = bf2f(rp[3712 + (lane & 15)]), p2 = bf2f(rp[3712 + 16 + (lane & 15)]);
                    float c6 = 1.f, s6 = 0.f, c3 = 1.f, s3 = 0.f;
                    if (!prompt) { c6 = cos64[s * 32 + dd]; s6 = sin64[s * 32 + dd]; c3 = cos32[s * 16 + (lane & 15)]; s3 = sin32[s * 16 + (lane & 15)]; }
                    float gq[6], gk[4];
#pragma unroll
                    for (int i = 0; i < 6; ++i) gq[i] = pk->in[18][l * 384 + lane + 64 * i];
#pragma unroll
                    for (int i = 0; i < 4; ++i) gk[i] = pk->in[19][l * 256 + lane + 64 * i];
                    float ssq = 0.f, ssk = 0.f;
#pragma unroll
                    for (int i = 0; i < 6; ++i) ssq += cqv[i] * cqv[i];
#pragma unroll
                    for (int i = 0; i < 4; ++i) ssk += ckvv[i] * ckvv[i];
                    const float rsq = rsqrtf(wave_sum(ssq) * (1.0f / 384.0f) + EPSF), rsk = rsqrtf(wave_sum(ssk) * (1.0f / 256.0f) + EPSF);
#pragma unroll
                    for (int i = 0; i < 8; ++i) { const int head = 2 * i + hq; const int cb = head < 8 ? head * 64 : 1536 + (head - 8) * 64; const float sc = (head >= 4 && head < 8) ? 0.125f : 1.0f;
                        const float x1 = ra[i] * sc, x2 = rb[i] * sc; rp[cb + dd] = f2bf(x1 * c6 - x2 * s6); rp[cb + dd + 32] = f2bf(x2 * c6 + x1 * s6); }
#pragma unroll
                    for (int i = 0; i < 4; ++i) { const int head = 2 * i + hq;
                        if (prompt) { float* od = pk->out + OUT_DK + orow * 512 + head * 64 + dd; od[0] = ka[i]; od[32] = kb[i]; }
                        DKV[kvrow * 1024 + head * 64 + dd] = f2bf(ka[i] * c6 - kb[i] * s6); DKV[kvrow * 1024 + head * 64 + dd + 32] = f2bf(kb[i] * c6 + ka[i] * s6); }
                    *(u32x4*)(DKV + kvrow * 1024 + 512 + 8 * lane) = dv;
                    if (prompt) { float* od = pk->out + OUT_DV + orow * 512 + 8 * lane; *(f32x4*)od = (f32x4){bf_lo(dv.x), bf_hi(dv.x), bf_lo(dv.y), bf_hi(dv.y)}; *(f32x4*)(od + 4) = (f32x4){bf_lo(dv.z), bf_hi(dv.z), bf_lo(dv.w), bf_hi(dv.w)}; }
#pragma unroll
                    for (int i = 0; i < 6; ++i) CQN[(size_t)r * 384 + lane + 64 * i] = f2bf(cqv[i] * rsq * gq[i]);
#pragma unroll
                    for (int i = 0; i < 4; ++i) { const float y = ckvv[i] * rsk * gk[i]; CKVN[kvrow * 256 + lane + 64 * i] = f2bf(y); if (prompt) pk->out[OUT_CKV + orow * 256 + lane + 64 * i] = y; }
                    if (lane < 16) {
                        if (prompt) { pk->out[OUT_KPE + orow * 32 + lane] = p1; pk->out[OUT_KPE + orow * 32 + 16 + lane] = p2; }
                        KPE[kvrow * 32 + lane] = f2bf(p1 * c3 - p2 * s3); KPE[kvrow * 32 + 16 + lane] = f2bf(p2 * c3 + p1 * s3); }
                } else {
                    const int cr = r - CHR, bb = cr >> 9, key = cr & 511; const size_t kvrow = (size_t)bb * LK + key; const size_t crow = ((size_t)(b0 + bb) * 2 + l) * 512 + key;
                    { const float* s0 = pk->in[4] + crow * 512 + 8 * lane; const float* s1 = pk->in[5] + crow * 512 + 8 * lane;
                      const f32x4 a = *(const f32x4*)s0, b = *(const f32x4*)(s0 + 4), c = *(const f32x4*)s1, d = *(const f32x4*)(s1 + 4), e = *(const f32x4*)(pk->in[6] + crow * 256 + 4 * lane);
                      const float kp = pk->in[7][crow * 32 + (lane & 31)];
                      u32x4 w; w.x = cvt_pk_bf16(a[0], a[1]); w.y = cvt_pk_bf16(a[2], a[3]); w.z = cvt_pk_bf16(b[0], b[1]); w.w = cvt_pk_bf16(b[2], b[3]); *(u32x4*)(DKV + kvrow * 1024 + 8 * lane) = w;
                      w.x = cvt_pk_bf16(c[0], c[1]); w.y = cvt_pk_bf16(c[2], c[3]); w.z = cvt_pk_bf16(d[0], d[1]); w.w = cvt_pk_bf16(d[2], d[3]); *(u32x4*)(DKV + kvrow * 1024 + 512 + 8 * lane) = w;
                      u32x2 w2; w2.x = cvt_pk_bf16(e[0], e[1]); w2.y = cvt_pk_bf16(e[2], e[3]); *(u32x2*)(CKVN + kvrow * 256 + 4 * lane) = w2;
                      if (lane < 32) KPE[kvrow * 32 + lane] = f2bf(kp); }
                }
            }
            if (ck > 0) { SUM_ROWS(pw0, pwn, row0 - CHR); }
            } }
        else if (kind == 4) { ENV LAYER_ENV CHUNK_ENV
            for (int prc_ = 0; prc_ < PROBE_C_REPS; ++prc_) {
            { pg8::Gemm g{CQN, (const bf16_t*)(wl + WO_UQ), CHR, 768, 384}; pg8::OffsetOrder S; S.init(CHR, 768, G, bx, 0); pg8::EpiRaw E{QMLA, 768};

          pg8::gemm_phase<pg8::EpiRaw, pg8::OffsetOrder, true, true>(lds, g, S, E);
 }
            { pg8::Gemm g{CKVN, (const bf16_t*)(wl + WO_UKV), KVR, 1024, 256}; pg8::OffsetOrder S; S.init(KVR, 1024, G, bx, 96 % G); pg8::EpiRaw E{KVMLA, 1024};

          pg8::gemm_phase<pg8::EpiRaw, pg8::OffsetOrder, true, true>(lds, g, S, E);
 }
            for (int u = (bx + G - (240 % G)) % G; u < 256; u += G) { const int h = u & 3;
ret_local_unit(lds, RAW, u >> 2, h, LGF(h), LGB(h), UST);
 }
            }
        }
        else if (kind == 5) { ENV LAYER_ENV CHUNK_ENV
            { const int nbat = prompt ? 32 : 2; const int total = nbat * 8 * 8192;
              for (int prb_ = 0; prb_ < PROBE_EW_REPS; ++prb_)
              for (int i = bx * NT + tid; i < total; i += G * NT) { const int e = i & 8191, rest = i >> 13, dir = rest & 1, h = (rest >> 1) & 3, bb = rest >> 3;
                  const float gC = __builtin_amdgcn_exp2f(128.0f * (dir == 0 ? LGF(h) : LGB(h)));
                  const size_t so = (((size_t)(b0 + bb) * 2 + l) * 4 + h) * 8192 + e;
                  float s = prompt ? 0.f : (dir == 0 ? pk->in[2][so] : pk->in[3][so]);
                  if (NCH >= 8) {
                      for (int c0 = 0; c0 < NCH; c0 += 8) { float uu[8]; size_t uo[8];
#pragma unroll
                          for (int k = 0; k < 8; ++k) { const int cc = c0 + k; const int c = dir == 0 ? cc : NCH - 1 - cc; uo[k] = ((size_t)(dir * 64 + bb * NCH + c) * 4 + h) * 8192 + e; uu[k] = UST[uo[k]]; }
#pragma unroll
                          for (int k = 0; k < 8; ++k) { SIN[uo[k]] = s; s = gC * s + uu[k]; } }
                  } else {
                      for (int c0 = 0; c0 < NCH; c0 += 2) { float uu[2]; size_t uo[2];
#pragma unroll
                          for (int k = 0; k < 2; ++k) { const int cc = c0 + k; const int c = dir == 0 ? cc : NCH - 1 - cc; uo[k] = ((size_t)(dir * 64 + bb * NCH + c) * 4 + h) * 8192 + e; uu[k] = UST[uo[k]]; }
#pragma unroll
                          for (int k = 0; k < 2; ++k) { SIN[uo[k]] = s; s = gC * s + uu[k]; } }
                  }
                  if (prompt) pk->out[(dir == 0 ? OUT_RF : OUT_RB) + so] = s; } } }
        else if (kind == 6) { ENV LAYER_ENV CHUNK_ENV
            for (int rep_ = 0; rep_ < PROBE_E_REPS; ++rep_) {
#if PROBE_FA_MODE
            if (!prompt) for (int u = vcu; u < 256; u += G) { const int qb = u % NQB, c = (u / NQB) & 1, h = (u / (2 * NQB)) & 3, bb = u / (8 * NQB); const size_t qrow = (size_t)bb * SEQL + qb * 256;
                fa_unit<64, 128, false, PROBE_FA_MODE>(lds, RAW + qrow * NINP + 1536 + h * 128 + c * 64, NINP, DKV + (size_t)bb * LK * 1024 + h * 128 + c * 64, 1024, nullptr, 0,
                                        DKV + (size_t)bb * LK * 1024 + 512 + h * 128, 1024, LK / 64, 0.125f * L2E, (float*)(ws + 432 * MiB) + ((size_t)c * CHR + qrow) * 512 + h * 128, 512); }
#endif
            { const float lam = lamv[l], lam_init = lamv[2 + l]; const int NQ2 = SEQL / 128;
            for (int u = vcu; u < 256; u += G) { const int qb = u % NQ2, h = (u / NQ2) & 3, bb = u / (4 * NQ2); const size_t qrow = (size_t)bb * SEQL + qb * 128;
                fa_unit<64, 128, true, true>(lds, RAW + qrow * NINP + 1536 + h * 128, NINP, DKV + (size_t)bb * LK * 1024 + h * 128, 1024, nullptr, 0,
                                             DKV + (size_t)bb * LK * 1024 + 512 + h * 128, 1024, LK / 64, 0.125f * L2E, YALL + ((size_t)CHR + qrow) * 512 + h * 128, 512, lam, 1.0f - lam_init); } }
            for (int u = vcu; u < 256; u += G) { const int qb = u % NQB, h = (u / NQB) & 7, bb = u / (8 * NQB); const size_t qrow = (size_t)bb * SEQL + qb * 256;
                fa_unit<96, 64, true>(lds, QMLA + qrow * 768 + h * 96, 768, KVMLA + (size_t)bb * LK * 1024 + h * 128, 1024, KPE + (size_t)bb * LK * 32, 32,
                                      KVMLA + (size_t)bb * LK * 1024 + h * 128 + 64, 1024, LK / 64, 0.10206207261596577f * L2E, YALL + ((size_t)2 * CHR + qrow) * 512 + h * 64, 512, 0.f, 1.f, prompt ? nullptr : cos32, sin32, qb * 256);
 }
            for (int pro_ = 0; pro_ < PROBE_O_REPS; ++pro_)
            for (int u = vcu; u < 256; u += G) { const int h = u & 3;
ret_out_unit(lds, RAW, u >> 2, h, LGF(h), LGB(h), SIN, YALL);
 }
            }
        }
        else if (kind == 7) { ENV LAYER_ENV CHUNK_ENV
            const float lam = lamv[l], lam_init = lamv[2 + l];
            for (int prb_ = 0; prb_ < PROBE_EW_REPS; ++prb_)
            for (int r = gw; r < CHR; r += NGW) {
                const float* o1 = ODIFF + (size_t)r * 512 + 8 * lane; const float* o2 = o1 + (size_t)CHR * 512;
                const f32x4 a0 = *(const f32x4*)o1, a1 = *(const f32x4*)(o1 + 4), b0v = *(const f32x4*)o2, b1v = *(const f32x4*)(o2 + 4);
                const f32x4 d0 = a0 - b0v * lam, d1 = a1 - b1v * lam;
                float ss = (d0[0] * d0[0] + d0[1] * d0[1]) + (d0[2] * d0[2] + d0[3] * d0[3]) + (d1[0] * d1[0] + d1[1] * d1[1]) + (d1[2] * d1[2] + d1[3] * d1[3]);
                ss += __shfl_xor(ss, 1); ss += __shfl_xor(ss, 2); ss += __shfl_xor(ss, 4); ss += __shfl_xor(ss, 8);
                const float sc = rsqrtf(ss * (1.0f / 128.0f) + EPSF) * (1.0f - lam_init);
                u32x4 w; w.x = cvt_pk_bf16(d0[0] * sc, d0[1] * sc); w.y = cvt_pk_bf16(d0[2] * sc, d0[3] * sc); w.z = cvt_pk_bf16(d1[0] * sc, d1[1] * sc); w.w = cvt_pk_bf16(d1[2] * sc, d1[3] * sc);
                *(u32x4*)(YALL + ((size_t)CHR + r) * 512 + 8 * lane) = w;
            } }
        else if (kind == 8) { ENV LAYER_ENV CHUNK_ENV
            for (int prg_ = 0; prg_ < PROBE_G4_REPS; ++prg_)
            { pg8::Gemm g{YALL, (const bf16_t*)(wl + WO_BR), 3 * CHR, 3072, 512}; pg8::GateOrder S{CHR / 256, G, bx}; pg8::EpiGate E{RAW, BRG, CHR / 256};

          pg8::gemm_phase<pg8::EpiGate, pg8::GateOrder, true, true>(lds, g, S, E);
 }
        }
        else if (kind == 9) { ENV LAYER_ENV
        for (int prr_ = 0; prr_ < PROBE_R_REPS; ++prr_)
        { pg8::Gemm g{ABUF, (const bf16_t*)(wl + WO_OUT), NTOK, DM, DM}; pg8::StaticOrder S; S.init(NTOK, DM, G, bx); pg8::EpiResid E{xs0, xs1, xres, modl + 2048, prr_ < PROBE_R_REPS - 1};

          pg8::gemm_phase<pg8::EpiResid, pg8::StaticOrder, true, true>(lds, g, S, E);
 }
        }
        else if (kind == 10) { ENV LAYER_ENV
        for (int prb_ = 0; prb_ < PROBE_EW_REPS; ++prb_)
        for (int m = gw; m < NTOK; m += NGW) {
            const int grp = m < NPR ? 0 : 1 + ((m - NPR) >> 12); const float* xr = xres + (size_t)m * DM; const float* md = modl + grp * 6144; const float* gn = pk->in[11] + l * DM;
            f32x4 v[4]; float ss = 0.f;
#pragma unroll
            for (int j = 0; j < 4; ++j) { v[j] = *(const f32x4*)(xr + 4 * lane + 256 * j); ss += (v[j][0] * v[j][0] + v[j][1] * v[j][1]) + (v[j][2] * v[j][2] + v[j][3] * v[j][3]); }
            const float rstd = rsqrtf(wave_sum(ss) * (1.0f / DM) + EPSF);
#pragma unroll
            for (int j = 0; j < 4; ++j) { const int c = 4 * lane + 256 * j; const f32x4 gg = *(const f32x4*)(gn + c), sh = *(const f32x4*)(md + 3072 + c), scv = *(const f32x4*)(md + 4096 + c);
                const f32x4 y = v[j] * rstd * gg * (scv + 1.0f) + sh; u32x2 pw; pw.x = cvt_pk_bf16(y[0], y[1]); pw.y = cvt_pk_bf16(y[2], y[3]);
                *(u32x2*)(ABUF + (size_t)m * DM + c) = pw; }
        } }
        else if (kind == 11) { ENV LAYER_ENV
            for (int prg_ = 0; prg_ < PROBE_G6_REPS; ++prg_)
        { pg8::Gemm g{ABUF, (const bf16_t*)(wl + WO_FI), NTOK, 5632, DM}; pg8::StaticOrder S; S.init(NTOK, 5632, G, bx); pg8::EpiSwiglu E{HID, 2816};

          pg8::gemm_phase<pg8::EpiSwiglu, pg8::StaticOrder, true, true>(lds, g, S, E);
 }
        }
        else if (kind == 12) { ENV LAYER_ENV
        for (int prr_ = 0; prr_ < PROBE_R_REPS; ++prr_)
        { pg8::Gemm g{HID, (const bf16_t*)(wl + WO_FO), NTOK, DM, 2816}; pg8::StaticOrder S; S.init(NTOK, DM, G, bx); pg8::EpiResid E{xres, xres, xres, modl + 5120, prr_ < PROBE_R_REPS - 1};

          pg8::gemm_phase<pg8::EpiResid, pg8::StaticOrder, true, true>(lds, g, S, E);
 }
        }
        else if (kind == 14) { ENV LAYER_ENV CHUNK_ENV
            SUM_ROWS(gw, NGW, row0);
        }
        else { ENV
    for (int m = gw; m < NTOK; m += NGW) {
        float* xr = xres + (size_t)m * DM; const float* gn = pk->in[26];
        f32x4 v[4]; float ss = 0.f;
#pragma unroll
        for (int j = 0; j < 4; ++j) { v[j] = *(const f32x4*)(xr + 4 * lane + 256 * j); ss += (v[j][0] * v[j][0] + v[j][1] * v[j][1]) + (v[j][2] * v[j][2] + v[j][3] * v[j][3]); }
        const float rstd = rsqrtf(wave_sum(ss) * (1.0f / DM) + EPSF);
        f32x4 gv[4];
#pragma unroll
        for (int j = 0; j < 4; ++j) gv[j] = *(const f32x4*)(gn + 4 * lane + 256 * j);
#pragma unroll
        for (int j = 0; j < 4; ++j) { const int c = 4 * lane + 256 * j; *(f32x4*)(xr + c) = v[j] * rstd * gv[j]; }
    } }
        if (ph != 73) {
            if (ph == 0) { KParams* pkc = (KParams*)__builtin_amdgcn_kernarg_segment_ptr(); if (pkc->out == nullptr) grid.sync(); }
            KParams* pkb = (KParams*)__builtin_amdgcn_kernarg_segment_ptr(); asm volatile("" : "+s"(pkb));
            XcdBarrier xb_; xb_.bar = (unsigned*)(pkb->ws + WS_CTL); xb_.x = xb_xcc_id(); xb_.st = (volatile LAS unsigned*)(lds + MISC_OFF) + 8; for (int rs_ = 0; rs_ < PROBE_SYNC_REPS; ++rs_) xcd_barrier(xb_); }
    }
}

extern "C" void kernel_launch(void* const* d_in, const int* in_sizes, int n_in, void* d_out, int out_size, void* d_ws, size_t ws_size, hipStream_t stream) {
    static int grid = 0;
    if (grid == 0) {
        if (n_in != 27 || (size_t)out_size != OUT_TOTAL || ws_size < WS_END) { fprintf(stderr, "kernel_launch: unexpected shapes (n_in %d out %d ws %zu)\n", n_in, out_size, ws_size); grid = -1; return; }
        int dev = 0, cus = 0, per_cu = 0;
        hipGetDevice(&dev); hipDeviceGetAttribute(&cus, hipDeviceAttributeMultiprocessorCount, dev);
        if (hipFuncSetAttribute((const void*)fwd_megakernel, hipFuncAttributeMaxDynamicSharedMemorySize, LDS_BYTES) != hipSuccess) { fprintf(stderr, "kernel_launch: hipFuncSetAttribute failed\n"); grid = -1; return; }
        if (hipOccupancyMaxActiveBlocksPerMultiprocessor(&per_cu, (const void*)fwd_megakernel, NT, LDS_BYTES) != hipSuccess || per_cu < 1) { fprintf(stderr, "kernel_launch: occupancy query says %d\n", per_cu); per_cu = 1; }
        (void)hipGetLastError();
        grid = cus;
    }
    if (grid < 0) return;
    if (hipMemsetAsync((char*)d_ws + WS_CTL, 0, 65536, stream) != hipSuccess) { fprintf(stderr, "kernel_launch: memset failed\n"); return; }
    Params p{};
    for (int i = 0; i < 27; ++i) p.in[i] = (const float*)d_in[i];
    p.out = (float*)d_out; p.ws = (unsigned char*)d_ws;
    void* args[] = {&p};
    hipError_t e = hipLaunchCooperativeKernel((const void*)fwd_megakernel, dim3(grid), dim3(NT), args, LDS_BYTES, stream);
    if (e != hipSuccess) fprintf(stderr, "cooperative launch failed: %s (grid %d)\n", hipGetErrorString(e), grid);
}
```
